# Optimizing an MI355X kernel written in HIP

```python
import math
import jax, jax.numpy as jnp
from jax import lax
import numpy as np

D_MODEL = 1024
BATCH = 4
SEQ = 8192
DEPTH = 4
DEC_BATCH = 8
DEC_SEQ = 64
PAST_LEN = 2048

CHUNK = 64
QUERY_BLOCK = 128
N_EVEN = (DEPTH + 1) // 2
N_ODD = DEPTH // 2
MLA_HEADS = 8
Q_RANK = 384
KV_RANK = 256
NOPE_DIM = 64
ROPE_DIM = 32
V_DIM = 64
ROPE_THETA = 10000.0
MLA_WIDTH = MLA_HEADS * V_DIM
SC_WIDTH = 512
SC_K = 3
MIX_E = MLA_WIDTH + SC_WIDTH
DN_HEADS = 8
DN_DK = 128
DN_DV = 128
DN_CONV = 4
DN_KEY = DN_HEADS * DN_DK
DN_VAL = DN_HEADS * DN_DV
DN_QKV = 2 * DN_KEY + DN_VAL
D_FF = 2816
FF_K = 3
EVEN_IN = Q_RANK + KV_RANK + ROPE_DIM + 3 * SC_WIDTH
E_SPLITS = (Q_RANK, Q_RANK + KV_RANK, Q_RANK + KV_RANK + ROPE_DIM,
            Q_RANK + KV_RANK + ROPE_DIM + SC_WIDTH, Q_RANK + KV_RANK + ROPE_DIM + 2 * SC_WIDTH)
ODD_IN = DN_QKV + DN_VAL + 2 * DN_HEADS
O_SPLITS = (DN_QKV, DN_QKV + DN_VAL, DN_QKV + DN_VAL + DN_HEADS)
ALPHA = (2 * DEPTH) ** 0.25
BETA_INIT = (8 * DEPTH) ** -0.25
NORM_EPS = 1e-6
NEG_INF = -1e30

kernel_name = "hybrid_mla_shortconv_gdn_convffn_stream_step"


def layer_norm(x, g, b):
    xf = x.astype(jnp.float32)
    mu = xf.mean(-1, keepdims=True)
    var = jnp.square(xf - mu).mean(-1, keepdims=True)
    return ((xf - mu) * lax.rsqrt(var + NORM_EPS) * g + b).astype(x.dtype)


def rms_norm(x, g):
    xf = x.astype(jnp.float32)
    return (xf * lax.rsqrt(jnp.mean(xf * xf, -1, keepdims=True) + NORM_EPS) * g).astype(x.dtype)


def l2_norm(x):
    xf = x.astype(jnp.float32)
    return xf * lax.rsqrt(jnp.sum(xf * xf, -1, keepdims=True) + NORM_EPS)


def causal_dwconv(x, w, buf):
    k = w.shape[0]
    s = x.shape[1]
    xp = jnp.concatenate([buf.astype(x.dtype), x], axis=1)
    y = xp[:, 0:s] * w[0]
    for i in range(1, k):
        y = y + xp[:, i:i + s] * w[i]
    return y, xp[:, xp.shape[1] - (k - 1):]


def rope(x, pos):
    half = ROPE_DIM // 2
    inv = ROPE_THETA ** (-jnp.arange(half, dtype=jnp.float32) / half)
    ang = pos.astype(jnp.float32)[:, None] * inv[None, :]
    cos = jnp.cos(ang)[None, :, None, :]
    sin = jnp.sin(ang)[None, :, None, :]
    xf = x.astype(jnp.float32)
    x1, x2 = xf[..., :half], xf[..., half:]
    return jnp.concatenate([x1 * cos - x2 * sin, x2 * cos + x1 * sin], -1).astype(x.dtype)


def chunk_attention(q, k, v, q_pos, k_pos):
    b, sq, h, dqk = q.shape
    dv = v.shape[-1]
    qb = QUERY_BLOCK if sq % QUERY_BLOCK == 0 else sq
    nb = sq // qb
    q_blocks = jnp.moveaxis(q.reshape(b, nb, qb, h, dqk), 1, 0)
    pos_blocks = q_pos.reshape(nb, qb)
    k_chunk = k_pos // CHUNK
    scale = (NOPE_DIM + ROPE_DIM) ** -0.5

    def one_block(args):
        qi, pi = args
        s = jnp.einsum('bqhd,bkhd->bhqk', qi, k).astype(jnp.float32) * scale
        visible = k_chunk[None, :] <= (pi // CHUNK)[:, None]
        s = jnp.where(visible[None, None], s, NEG_INF)
        p = jax.nn.softmax(s, axis=-1).astype(v.dtype)
        return jnp.einsum('bhqk,bkhd->bqhd', p, v)

    o = lax.map(one_block, (q_blocks, pos_blocks))
    return jnp.moveaxis(o, 0, 1).reshape(b, sq, h * dv)


def even_mixer(x, q_pos, k_pos, past_lat, past_kr, sc_buf, w_in, g_q, g_kv, w_uq, w_ukv, sc_w, w_o):
    b, s, _ = x.shape
    h = x @ w_in
    c_q, c_kv, k_r, gate_b, gate_c, sh = jnp.split(h, list(E_SPLITS), axis=-1)
    q = (rms_norm(c_q, g_q) @ w_uq).reshape(b, s, MLA_HEADS, NOPE_DIM + ROPE_DIM)
    q = jnp.concatenate([q[..., :NOPE_DIM], rope(q[..., NOPE_DIM:], q_pos)], -1)
    lat = rms_norm(c_kv, g_kv)
    kr = rope(k_r[:, :, None, :], q_pos)[:, :, 0]
    lat_all = jnp.concatenate([past_lat.astype(x.dtype), lat], 1)
    kr_all = jnp.concatenate([past_kr.astype(x.dtype), kr], 1)
    t = lat_all.shape[1]
    kv = (lat_all @ w_ukv).reshape(b, t, MLA_HEADS, NOPE_DIM + V_DIM)
    k = jnp.concatenate([kv[..., :NOPE_DIM],
                         jnp.broadcast_to(kr_all[:, :, None, :], (b, t, MLA_HEADS, ROPE_DIM))], -1)
    v = kv[..., NOPE_DIM:]
    o_att = chunk_attention(q, k, v, q_pos, k_pos)
    u, sc_new = causal_dwconv(gate_c * sh, sc_w, sc_buf)
    o_sc = gate_b * u
    y = jnp.concatenate([o_att, o_sc], -1) @ w_o
    return y, lat, kr, sc_new


def gated_delta_chunked(q, k, v, g, beta, s0):
    f32 = jnp.float32
    b, s, h, dk = q.shape
    dv = v.shape[-1]
    L = CHUNK if s % CHUNK == 0 else s
    n = s // L

    def blk(t):
        t = t.astype(f32).reshape((b, n, L, h) + t.shape[3:])
        return jnp.moveaxis(t, 3, 1)

    q, k, v, g, beta = blk(q), blk(k), blk(v), blk(g), blk(beta)
    G = jnp.cumsum(g, axis=-1)
    tri = jnp.tril(jnp.ones((L, L), bool))
    strict = jnp.tril(jnp.ones((L, L), bool), -1)
    decay = jnp.exp(jnp.where(tri, G[..., :, None] - G[..., None, :], -jnp.inf))
    kb = k * beta[..., None]
    m = jnp.where(strict, jnp.einsum('bhnid,bhnjd->bhnij', kb, k) * decay, 0.0)
    a = m + jnp.eye(L, dtype=f32)
    rhs = jnp.concatenate([v * beta[..., None], kb * jnp.exp(G)[..., None]], -1)
    sol = lax.linalg.triangular_solve(a, rhs, left_side=True, lower=True, unit_diagonal=True)
    w_val, k_cd = sol[..., :dv], sol[..., dv:]
    attn = jnp.einsum('bhnid,bhnjd->bhnij', q, k) * decay
    q_dec = q * jnp.exp(G)[..., None]
    g_last = G[..., -1:]
    k_tail = k * jnp.exp(g_last - G)[..., None]
    g_tot = jnp.exp(g_last[..., 0])

    def step(st, inp):
        qd, kcd, wv, at, kt, gt = inp
        v_new = wv - jnp.einsum('bhld,bhde->bhle', kcd, st)
        o = jnp.einsum('bhld,bhde->bhle', qd, st) + jnp.einsum('bhij,bhje->bhie', at, v_new)
        st = st * gt[..., None, None] + jnp.einsum('bhld,bhle->bhde', kt, v_new)
        return st, o

    xs = tuple(jnp.moveaxis(t, 2, 0) for t in (q_dec, k_cd, w_val, attn, k_tail, g_tot))
    s_fin, o = lax.scan(step, s0.astype(f32), xs)
    o = jnp.moveaxis(jnp.moveaxis(o, 0, 2), 1, 3).reshape(b, s, h, dv)
    return o, s_fin


def odd_mixer(x, dconv_buf, s0, w_in, dconv_w, a_log, dt_bias, g_o, w_o):
    b, s, _ = x.shape
    h = x @ w_in
    qkv, z, a, bt = jnp.split(h, list(O_SPLITS), axis=-1)
    qkv, dconv_new = causal_dwconv(qkv, dconv_w, dconv_buf)
    qkv = jax.nn.silu(qkv)
    q, k, v = jnp.split(qkv, [DN_KEY, 2 * DN_KEY], axis=-1)
    q = l2_norm(q.reshape(b, s, DN_HEADS, DN_DK)) * (DN_DK ** -0.5)
    k = l2_norm(k.reshape(b, s, DN_HEADS, DN_DK))
    v = v.reshape(b, s, DN_HEADS, DN_DV)
    beta = jax.nn.sigmoid(bt.astype(jnp.float32))
    g = -jnp.exp(a_log.astype(jnp.float32)) * jax.nn.softplus(a.astype(jnp.float32) + dt_bias)
    o, s_new = gated_delta_chunked(q, k, v, g, beta, s0)
    o = rms_norm(o, g_o) * jax.nn.silu(z.reshape(b, s, DN_HEADS, DN_DV).astype(jnp.float32))
    y = o.astype(x.dtype).reshape(b, s, DN_VAL) @ w_o
    return y, dconv_new, s_new.astype(s0.dtype)


def conv_ffn(x, buf, w_in, conv_w, w_out):
    h = x @ w_in
    gate, up = h[..., :D_FF], h[..., D_FF:]
    gate, buf_new = causal_dwconv(gate, conv_w, buf)
    return (jax.nn.silu(gate) * up) @ w_out, buf_new


def trunk(x, past_lat, past_kr, sc_buf, dconv_buf, delta_s, ff_buf, w):
    (w_in_e, g_qnorm, g_kvnorm, w_uq, w_ukv, sc_w, w_o_e, w_in_o, dconv_w, a_log, dt_bias,
     g_onorm, w_o_o, w_ff_in, ffconv_w, w_ff_out, ln_mix_g, ln_mix_b, ln_ff_g, ln_ff_b) = w
    s = x.shape[1]
    p = past_lat.shape[2]
    q_pos = p + jnp.arange(s, dtype=jnp.int32)
    k_pos = jnp.arange(p + s, dtype=jnp.int32)
    lats, krs, scs, dcs, dss, ffs = [], [], [], [], [], []
    for i in range(DEPTH):
        if i % 2 == 0:
            e = i // 2
            y, lat, kr, scb = even_mixer(x, q_pos, k_pos, past_lat[e], past_kr[e], sc_buf[e],
                                         w_in_e[e], g_qnorm[e], g_kvnorm[e], w_uq[e], w_ukv[e],
                                         sc_w[e], w_o_e[e])
            lats.append(lat); krs.append(kr); scs.append(scb)
        else:
            o = i // 2
            y, dcb, st = odd_mixer(x, dconv_buf[o], delta_s[o], w_in_o[o], dconv_w[o], a_log[o],
                                   dt_bias[o], g_onorm[o], w_o_o[o])
            dcs.append(dcb); dss.append(st)
        x = layer_norm(ALPHA * x + y, ln_mix_g[i], ln_mix_b[i])
        y, ffb = conv_ffn(x, ff_buf[i], w_ff_in[i], ffconv_w[i], w_ff_out[i])
        ffs.append(ffb)
        x = layer_norm(ALPHA * x + y, ln_ff_g[i], ln_ff_b[i])
    return (x, jnp.stack(lats), jnp.stack(krs), jnp.stack(scs), jnp.stack(dcs),
            jnp.stack(dss), jnp.stack(ffs))


def setup_inputs(seed: int = 0) -> dict:
    key = jax.random.key(seed)
    ks = jax.random.split(key, 32)
    f32 = jnp.float32

    def nrm(k, shape, scale):
        return jax.random.normal(k, shape, f32) * scale

    dt = jnp.exp(jax.random.uniform(ks[20], (N_ODD, DN_HEADS), f32, math.log(1e-3), math.log(1e-1)))
    return {
        "x_prompt": nrm(ks[0], (BATCH, SEQ, D_MODEL), 1.0),
        "x_sample": nrm(ks[1], (DEC_BATCH, DEC_SEQ, D_MODEL), 1.0),
        "cache_mla_latent": nrm(ks[2], (N_EVEN, DEC_BATCH, PAST_LEN, KV_RANK), 1.0),
        "cache_mla_krope": nrm(ks[3], (N_EVEN, DEC_BATCH, PAST_LEN, ROPE_DIM), 1.0),
        "state_sconv": nrm(ks[4], (N_EVEN, DEC_BATCH, SC_K - 1, SC_WIDTH), 1.0),
        "state_dconv": nrm(ks[5], (N_ODD, DEC_BATCH, DN_CONV - 1, DN_QKV), 1.0),
        "state_delta": nrm(ks[6], (N_ODD, DEC_BATCH, DN_HEADS, DN_DK, DN_DV), DN_DK ** -0.5),
        "state_ffconv": nrm(ks[7], (DEPTH, DEC_BATCH, FF_K - 1, D_FF), 1.0),
        "w_in_e": nrm(ks[8], (N_EVEN, D_MODEL, EVEN_IN), D_MODEL ** -0.5),
        "g_qnorm": 1.0 + nrm(ks[9], (N_EVEN, Q_RANK), 0.01),
        "g_kvnorm": 1.0 + nrm(ks[10], (N_EVEN, KV_RANK), 0.01),
        "w_uq": nrm(ks[11], (N_EVEN, Q_RANK, MLA_HEADS * (NOPE_DIM + ROPE_DIM)), Q_RANK ** -0.5),
        "w_ukv": nrm(ks[12], (N_EVEN, KV_RANK, MLA_HEADS * (NOPE_DIM + V_DIM)), KV_RANK ** -0.5),
        "sc_w": nrm(ks[13], (N_EVEN, SC_K, SC_WIDTH), SC_K ** -0.5),
        "w_o_e": nrm(ks[14], (N_EVEN, MIX_E, D_MODEL), MIX_E ** -0.5 * BETA_INIT),
        "w_in_o": nrm(ks[15], (N_ODD, D_MODEL, ODD_IN), D_MODEL ** -0.5),
        "dconv_w": nrm(ks[16], (N_ODD, DN_CONV, DN_QKV), DN_CONV ** -0.5),
        "a_log": jnp.log(jax.random.uniform(ks[17], (N_ODD, DN_HEADS), f32, 1.0, 16.0)),
        "dt_bias": dt + jnp.log(-jnp.expm1(-dt)),
        "g_onorm": 1.0 + nrm(ks[18], (N_ODD, DN_DV), 0.01),
        "w_o_o": nrm(ks[19], (N_ODD, DN_VAL, D_MODEL), DN_VAL ** -0.5 * BETA_INIT),
        "w_ff_in": nrm(ks[21], (DEPTH, D_MODEL, 2 * D_FF), D_MODEL ** -0.5),
        "ffconv_w": nrm(ks[22], (DEPTH, FF_K, D_FF), FF_K ** -0.5),
        "w_ff_out": nrm(ks[23], (DEPTH, D_FF, D_MODEL), D_FF ** -0.5 * BETA_INIT),
        "ln_mix_g": 1.0 + nrm(ks[24], (DEPTH, D_MODEL), 0.01),
        "ln_mix_b": nrm(ks[25], (DEPTH, D_MODEL), 0.01),
        "ln_ff_g": 1.0 + nrm(ks[26], (DEPTH, D_MODEL), 0.01),
        "ln_ff_b": nrm(ks[27], (DEPTH, D_MODEL), 0.01),
    }


def reference(x_prompt, x_sample, cache_mla_latent, cache_mla_krope, state_sconv, state_dconv,
              state_delta, state_ffconv, w_in_e, g_qnorm, g_kvnorm, w_uq, w_ukv, sc_w, w_o_e,
              w_in_o, dconv_w, a_log, dt_bias, g_onorm, w_o_o, w_ff_in, ffconv_w, w_ff_out,
              ln_mix_g, ln_mix_b, ln_ff_g, ln_ff_b):
    w = (w_in_e, g_qnorm, g_kvnorm, w_uq, w_ukv, sc_w, w_o_e, w_in_o, dconv_w, a_log, dt_bias,
         g_onorm, w_o_o, w_ff_in, ffconv_w, w_ff_out, ln_mix_g, ln_mix_b, ln_ff_g, ln_ff_b)
    bp = x_prompt.shape[0]
    dt = x_prompt.dtype
    y_p, p_lat, p_kr, p_sc, p_dc, p_ds, p_ff = trunk(
        x_prompt,
        jnp.zeros((N_EVEN, bp, 0, KV_RANK), dt),
        jnp.zeros((N_EVEN, bp, 0, ROPE_DIM), dt),
        jnp.zeros((N_EVEN, bp, SC_K - 1, SC_WIDTH), dt),
        jnp.zeros((N_ODD, bp, DN_CONV - 1, DN_QKV), dt),
        jnp.zeros((N_ODD, bp, DN_HEADS, DN_DK, DN_DV), dt),
        jnp.zeros((DEPTH, bp, FF_K - 1, D_FF), dt),
        w)
    y_s, s_lat, s_kr, s_sc, s_dc, s_ds, s_ff = trunk(
        x_sample, cache_mla_latent, cache_mla_krope, state_sconv, state_dconv, state_delta,
        state_ffconv, w)
    return (y_p, y_s, p_lat, p_kr, p_sc, p_dc, p_ds, p_ff, s_lat, s_kr, s_sc, s_dc, s_ds, s_ff)
```

```cpp
#include <hip/hip_runtime.h>
#include <hip/hip_cooperative_groups.h>
#include <cstdio>
#include <cstdint>
namespace cg = cooperative_groups;

typedef unsigned short bf16_t;
typedef short bf16x8 __attribute__((ext_vector_type(8)));
typedef float f32x4 __attribute__((ext_vector_type(4)));
#define DI __device__ __forceinline__
#define MFMA16(a, b, c) __builtin_amdgcn_mfma_f32_16x16x32_bf16((a), (b), (c), 0, 0, 0)

constexpr int MP = 32768, MS = 512, MT = 33280;
constexpr int KVROWS = 32768 + 8 * 2112;
constexpr float ALPHA = 1.681792830507429f;
constexpr float EPS = 1e-6f;

constexpr size_t O_YP = 0;
constexpr size_t O_YS = O_YP + (size_t)4 * 8192 * 1024;
constexpr size_t O_PLAT = O_YS + (size_t)8 * 64 * 1024;
constexpr size_t O_PKR = O_PLAT + (size_t)2 * 4 * 8192 * 256;
constexpr size_t O_PSC = O_PKR + (size_t)2 * 4 * 8192 * 32;
constexpr size_t O_PDC = O_PSC + (size_t)2 * 4 * 2 * 512;
constexpr size_t O_PDS = O_PDC + (size_t)2 * 4 * 3 * 3072;
constexpr size_t O_PFF = O_PDS + (size_t)2 * 4 * 8 * 128 * 128;
constexpr size_t O_SLAT = O_PFF + (size_t)4 * 4 * 2 * 2816;
constexpr size_t O_SKR = O_SLAT + (size_t)2 * 8 * 64 * 256;
constexpr size_t O_SSC = O_SKR + (size_t)2 * 8 * 64 * 32;
constexpr size_t O_SDC = O_SSC + (size_t)2 * 8 * 2 * 512;
constexpr size_t O_SDS = O_SDC + (size_t)2 * 8 * 3 * 3072;
constexpr size_t O_SFF = O_SDS + (size_t)2 * 8 * 8 * 128 * 128;
constexpr size_t O_END = O_SFF + (size_t)4 * 8 * 2 * 2816;

constexpr size_t WS_WB = 0;
constexpr size_t WS_XB = 32ull << 20;
constexpr size_t WS_ROPE = WS_XB + (size_t)MT * 1024 * 2;
constexpr size_t WS_GB = WS_ROPE + 8192 * 16 * 8;
constexpr size_t WS_ABF = WS_GB + (size_t)MT * 16 * 4;
constexpr size_t WS_HALO = WS_ABF + (size_t)MT * 16 * 4;
constexpr size_t WS_HEADG = WS_HALO + (size_t)260 * 2 * 2816 * 4;
constexpr size_t WS_HEADU = WS_HEADG + (size_t)260 * 2 * 2816 * 4;
constexpr size_t WS_R1 = 120ull << 20;
constexpr size_t R_SIZE = (size_t)MT * 3072 * 2;
constexpr size_t WS_R2 = 316ull << 20;
constexpr size_t WS_NEED = WS_R2 + R_SIZE;
static_assert(WS_HEADU + (size_t)260 * 2 * 2816 * 4 <= WS_R1, "ws small region overflow");
static_assert(WS_R1 + R_SIZE <= WS_R2, "ws r1 overflow");
static_assert(WS_NEED <= (512ull << 20), "ws overflow");

constexpr size_t WB_IN = 0;
constexpr size_t WB_UQ = WB_IN + (size_t)4352 * 1024;
constexpr size_t WB_UKV = WB_UQ + (size_t)768 * 384;
constexpr size_t WB_O = WB_UKV + (size_t)1024 * 256;
constexpr size_t WB_FI = WB_O + (size_t)1024 * 1024;
constexpr size_t WB_FO = WB_FI + (size_t)5632 * 1024;
static_assert((WB_FO + (size_t)1024 * 2816) * 2 <= (32ull << 20), "wb overflow");

constexpr int NT = 512;
constexpr unsigned LDS_BYTES = 147456;
extern __shared__ __attribute__((aligned(16))) unsigned char dsm[];

struct Params {
    const float* in[28];
    float* out;
    unsigned char* ws;
};

typedef __bf16 bf16n2 __attribute__((ext_vector_type(2)));
typedef float f32n2 __attribute__((ext_vector_type(2)));
DI bf16_t f2bf(float x) { return __builtin_bit_cast(unsigned short, (__bf16)x); }
DI float bf2f(bf16_t h) { return __uint_as_float(((unsigned)h) << 16); }
DI unsigned pack2(float lo, float hi) { const f32n2 v = {lo, hi}; return __builtin_bit_cast(unsigned, __builtin_convertvector(v, bf16n2)); }
DI float lo16(unsigned u) { return __uint_as_float(u << 16); }
DI float hi16(unsigned u) { return __uint_as_float(u & 0xffff0000u); }
struct F8 { float v[8]; };
DI F8 unpack8(uint4 u) { F8 r; r.v[0] = lo16(u.x); r.v[1] = hi16(u.x); r.v[2] = lo16(u.y); r.v[3] = hi16(u.y); r.v[4] = lo16(u.z); r.v[5] = hi16(u.z); r.v[6] = lo16(u.w); r.v[7] = hi16(u.w); return r; }
DI uint4 pack8(const F8& f) { uint4 u; u.x = pack2(f.v[0], f.v[1]); u.y = pack2(f.v[2], f.v[3]); u.z = pack2(f.v[4], f.v[5]); u.w = pack2(f.v[6], f.v[7]); return u; }
DI F8 ldf8(const float* p) { float4 a = *(const float4*)p, b = *(const float4*)(p + 4); F8 r; r.v[0] = a.x; r.v[1] = a.y; r.v[2] = a.z; r.v[3] = a.w; r.v[4] = b.x; r.v[5] = b.y; r.v[6] = b.z; r.v[7] = b.w; return r; }
DI void stf8(float* p, const F8& f) { *(float4*)p = make_float4(f.v[0], f.v[1], f.v[2], f.v[3]); *(float4*)(p + 4) = make_float4(f.v[4], f.v[5], f.v[6], f.v[7]); }
DI F8 ldb8(const bf16_t* p) { return unpack8(*(const uint4*)p); }
DI void stb8(bf16_t* p, const F8& f) { *(uint4*)p = pack8(f); }
DI float wsum(float v) { v += __shfl_xor(v, 32); v += __shfl_xor(v, 16); v += __shfl_xor(v, 8); v += __shfl_xor(v, 4); v += __shfl_xor(v, 2); v += __shfl_xor(v, 1); return v; }
DI float gsum16(float v) { v += __shfl_xor(v, 8); v += __shfl_xor(v, 4); v += __shfl_xor(v, 2); v += __shfl_xor(v, 1); return v; }
DI float siluf(float x) { return x / (1.f + __expf(-x)); }
DI bf16x8 asbf(uint4 u) { return __builtin_bit_cast(bf16x8, u); }
DI uint4 scale8(uint4 u, float s) { F8 f = unpack8(u); for (int e = 0; e < 8; ++e) f.v[e] *= s; return pack8(f); }

DI int tidx() { int t = threadIdx.x; asm volatile("" : "+v"(t)); return t; }
DI int bidx() { int b = blockIdx.x; asm volatile("" : "+s"(b)); return b; }
DI int gdim() { int g = gridDim.x; asm volatile("" : "+s"(g)); return g; }
DI void rowinfo(int r, int& sq, int& pos, int& len) { if (r < MP) { sq = r >> 13; pos = r & 8191; len = 8192; } else { sq = 4 + ((r - MP) >> 6); pos = r & 63; len = 64; } }
DI int kvrow_of(int r) { return r < MP ? r : MP + ((r - MP) >> 6) * 2112 + 2048 + (r & 63); }

DI void wconv(const float* __restrict__ src, bf16_t* __restrict__ dst, int K, int N, int Npad, int perm, unsigned char* smem, int vb, int nb) {
    float* tile = (float*)smem;
    const int tid = tidx();
    const int nkt = K >> 6, nnt = (Npad + 63) >> 6, T = nkt * nnt;
    for (int t = vb; t < T; t += nb) {
        const int kt = t % nkt, ntile = t / nkt, k0 = kt * 64, n0 = ntile * 64;
#pragma unroll
        for (int j = 0; j < 2; ++j) {
            const int k = (tid >> 4) + 32 * j, nl4 = (tid & 15) * 4, n = n0 + nl4;
            float4 v = make_float4(0.f, 0.f, 0.f, 0.f);
            if (n < N) v = *(const float4*)(src + (size_t)(k0 + k) * N + n);
            float* tp = tile + k * 65 + nl4; tp[0] = v.x; tp[1] = v.y; tp[2] = v.z; tp[3] = v.w;
        }
        __syncthreads();
        const int nl = tid >> 3, kc = (tid & 7) * 8, n = n0 + nl;
        if (n < Npad) {
            int nd = n;
            if (perm) nd = n < 2816 ? (n >> 6) * 128 + (n & 63) : ((n - 2816) >> 6) * 128 + 64 + ((n - 2816) & 63);
            F8 a;
#pragma unroll
            for (int e = 0; e < 8; ++e) a.v[e] = tile[(kc + e) * 65 + nl];
            stb8(dst + (size_t)nd * K + k0 + kc, a);
        }
        __syncthreads();
    }
}

DI void wconv_part(const Params& p, int layer, int part, unsigned char* smem, int vb, int nb) {
    bf16_t* WB = (bf16_t*)(p.ws + WS_WB);
    if (part == 0) {
        if ((layer & 1) == 0) {
            const int e = layer >> 1;
            wconv(p.in[8] + (size_t)e * 1024 * 2208, WB + WB_IN, 1024, 2208, 2304, 0, smem, vb, nb);
            wconv(p.in[11] + (size_t)e * 384 * 768, WB + WB_UQ, 384, 768, 768, 0, smem, vb, nb);
            wconv(p.in[12] + (size_t)e * 256 * 1024, WB + WB_UKV, 256, 1024, 1024, 0, smem, vb, nb);
            wconv(p.in[14] + (size_t)e * 1024 * 1024, WB + WB_O, 1024, 1024, 1024, 0, smem, vb, nb);
        } else {
            const int o = layer >> 1;
            wconv(p.in[15] + (size_t)o * 1024 * 4112, WB + WB_IN, 1024, 4112, 4352, 0, smem, vb, nb);
            wconv(p.in[20] + (size_t)o * 1024 * 1024, WB + WB_O, 1024, 1024, 1024, 0, smem, vb, nb);
        }
    } else {
        wconv(p.in[21] + (size_t)layer * 1024 * 5632, WB + WB_FI, 1024, 5632, 5632, 1, smem, vb, nb);
        wconv(p.in[23] + (size_t)layer * 2816 * 1024, WB + WB_FO, 2816, 1024, 1024, 0, smem, vb, nb);
    }
}

DI void prep_phase(const Params& p) {
    bf16_t* XB = (bf16_t*)(p.ws + WS_XB);
    const size_t gt = (size_t)bidx() * NT + tidx(), gn = (size_t)gdim() * NT;
    for (size_t i = gt; i < (size_t)MT * 128; i += gn) {
        const size_t e = i * 8;
        const float* s = e < (size_t)MP * 1024 ? p.in[0] + e : p.in[1] + (e - (size_t)MP * 1024);
        stb8(XB + e, ldf8(s));
    }
    float2* R = (float2*)(p.ws + WS_ROPE);
    for (size_t i = gt; i < 8192 * 16; i += gn) {
        const int pos = (int)(i >> 4), j = (int)(i & 15);
        const double base[4] = {1.0, 0.5623413251903491, 0.31622776601683794, 0.1778279410038923};
        double inv = base[j & 3];
        const int q = j >> 2;
        inv = q == 0 ? inv : q == 1 ? inv * 0.1 : q == 2 ? inv * 0.01 : inv * 0.001;
        const float ang = (float)pos * (float)inv;
        const double rev = (double)ang * 0.15915494309189535;
        const float fr = (float)(rev - floor(rev));
        R[i] = make_float2(__builtin_amdgcn_cosf(fr), __builtin_amdgcn_sinf(fr));
    }
}

struct Epi {
    bf16_t* b0; bf16_t* b1; float* f0; float* f1; float* f2;
    const float* c0; const float* c1; const float2* rope;
    float* out; int ld; int layer;
};
constexpr int LDC = 132;

template <int MODE>
DI void gemm_epilogue(const float* Cs, int m0, int n0, const Epi& ep) {
    const int tid = tidx();
    if (MODE == 0) {
#pragma unroll
        for (int it = 0; it < 4; ++it) {
            const int row = (tid >> 4) + 32 * it, cc = (tid & 15) * 8;
            stb8(ep.b0 + (size_t)(m0 + row) * ep.ld + n0 + cc, ldf8(Cs + row * LDC + cc));
        }
    } else if (MODE == 1) {
        const float qs = 0.10206207261596575f * 1.4426950408889634f;
#pragma unroll
        for (int it = 0; it < 4; ++it) {
            const int row = (tid >> 4) + 32 * it, cc = (tid & 15) * 8, col = n0 + cc, hc = col % 96;
            F8 x = ldf8(Cs + row * LDC + cc);
            if (hc >= 64) {
                int sq, pos, len; rowinfo(m0 + row, sq, pos, len); if (sq >= 4) pos += 2048;
                const bool first = hc < 80;
                const int j0 = first ? hc - 64 : hc - 80;
                F8 y = ldf8(Cs + row * LDC + (first ? cc + 16 : cc - 16));
                const float2* rp = ep.rope + pos * 16 + j0;
#pragma unroll
                for (int e = 0; e < 8; ++e) { const float2 cs = rp[e]; x.v[e] = first ? x.v[e] * cs.x - y.v[e] * cs.y : x.v[e] * cs.x + y.v[e] * cs.y; }
            }
#pragma unroll
            for (int e = 0; e < 8; ++e) x.v[e] *= qs;
            stb8(ep.b0 + (size_t)(m0 + row) * 768 + col, x);
        }
    } else if (MODE == 2) {
        const int h = n0 >> 7;
#pragma unroll
        for (int it = 0; it < 2; ++it) {
            const int row = (tid >> 3) + 64 * it, cc = (tid & 7) * 8;
            stb8(ep.b0 + (size_t)(m0 + row) * 768 + h * 96 + cc, ldf8(Cs + row * LDC + cc));
        }
        const int dv = tid >> 3;
#pragma unroll
        for (int jj = 0; jj < 2; ++jj) {
            const int t8 = ((tid & 7) + 8 * jj) * 8, kvr = m0 + t8;
            size_t vb; int Ts, t;
            if (kvr < MP) { vb = (size_t)(kvr >> 13) * (512 * 8192); Ts = 8192; t = kvr & 8191; }
            else { const int s = (kvr - MP) / 2112; vb = (size_t)4 * 512 * 8192 + (size_t)s * (512 * 2112); Ts = 2112; t = kvr - MP - s * 2112; }
            F8 x;
#pragma unroll
            for (int e = 0; e < 8; ++e) x.v[e] = Cs[(t8 + e) * LDC + 64 + dv];
            stb8(ep.b1 + vb + (size_t)(h * 64 + dv) * Ts + t, x);
        }
    } else if (MODE == 3) {
        if (n0 < 4224) {
        bf16_t* dst = n0 < 3072 ? ep.b0 : ep.b1;
        const int ld = n0 < 3072 ? 3072 : 1152, c0 = n0 < 3072 ? n0 : n0 - 3072;
#pragma unroll
        for (int it = 0; it < 4; ++it) {
            const int row = (tid >> 4) + 32 * it, cc = (tid & 15) * 8;
            stb8(dst + (size_t)(m0 + row) * ld + c0 + cc, ldf8(Cs + row * LDC + cc));
        }
        if (n0 == 4096) {
            const int row = tid >> 2, c4 = (tid & 3) * 4;
            *(float4*)(ep.f0 + (size_t)(m0 + row) * 16 + c4) = *(const float4*)(Cs + row * LDC + c4);
        }
        }
    } else if (MODE == 4) {
        const int mt = m0 >> 7, ch0 = (n0 >> 7) * 64, c8 = (tid & 7) * 8, ch = ch0 + c8;
        const float* cw = ep.c0;
        const F8 w0 = ldf8(cw + ch), w1 = ldf8(cw + 2816 + ch), w2 = ldf8(cw + 2 * 2816 + ch);
        const bool defer01 = (m0 < MP) && ((m0 & 8191) != 0);
#pragma unroll
        for (int it = 0; it < 2; ++it) {
            const int i = (tid >> 3) + 64 * it, r = m0 + i;
            int sq, pos, len; rowinfo(r, sq, pos, len);
            const F8 g0 = ldf8(Cs + i * LDC + c8), up = ldf8(Cs + i * LDC + 64 + c8);
            if (i >= 126) stf8(ep.f0 + ((size_t)mt * 2 + (i - 126)) * 2816 + ch, g0);
            if (i < 2) { stf8(ep.f1 + ((size_t)mt * 2 + i) * 2816 + ch, g0); stf8(ep.f2 + ((size_t)mt * 2 + i) * 2816 + ch, up); }
            if (pos >= len - 2) {
                float* so = sq < 4 ? ep.out + O_PFF + (((size_t)ep.layer * 4 + sq) * 2 + (pos - (len - 2))) * 2816
                                   : ep.out + O_SFF + (((size_t)ep.layer * 8 + (sq - 4)) * 2 + (pos - (len - 2))) * 2816;
                stf8(so + ch, g0);
            }
            if (i < 2 && defer01) continue;
            F8 g1, g2;
            const float* hist = sq >= 4 ? ep.c1 + ((size_t)ep.layer * 8 + (sq - 4)) * 2 * 2816 + ch : nullptr;
            if (pos >= 1) g1 = ldf8(Cs + (i - 1) * LDC + c8);
            else if (hist) g1 = ldf8(hist + 2816);
            else { for (int e = 0; e < 8; ++e) g1.v[e] = 0.f; }
            if (pos >= 2) g2 = ldf8(Cs + (i - 2) * LDC + c8);
            else if (hist) g2 = ldf8(hist + (size_t)pos * 2816);
            else { for (int e = 0; e < 8; ++e) g2.v[e] = 0.f; }
            F8 o;
#pragma unroll
            for (int e = 0; e < 8; ++e) o.v[e] = siluf(w0.v[e] * g2.v[e] + w1.v[e] * g1.v[e] + w2.v[e] * g0.v[e]) * up.v[e];
            stb8(ep.b0 + (size_t)r * 2816 + ch, o);
        }
    }
}

namespace g8 {
constexpr int BM = 256, BK = 64, HALF = 128, NXCD = 8, WGM = 8, HT = HALF * BK;
DI int lds_byte(int r, int c) { int st = (r >> 4) * 2 + (c >> 5), rr = r & 15, cc = c & 31, ob = rr * 64 + cc * 2; return st * 1024 + (ob ^ (((ob >> 9) & 1) << 5)); }
DI void stage_rc(int b, int& R, int& C) { int st = b / 1024, sb = b % 1024, swz = sb ^ (((sb >> 9) & 1) << 5); R = (st >> 1) * 16 + swz / 64; C = (st & 1) * 32 + (swz % 64) / 2; }
}
template <int MODE>
DI void gemm_phase(const bf16_t* __restrict__ A, const bf16_t* __restrict__ Bt, int M, int N, int K, const Epi& ep, int rot = 0) {
    using namespace g8;
    bf16_t* shm = (bf16_t*)dsm;
    float* Cs = (float*)dsm;
#define SA(b, h) (shm + ((b) * 2 + (h)) * HT)
#define SB(b, h) (shm + (4 + (b) * 2 + (h)) * HT)
#define STAGE(P, RS, br, kt) do { const unsigned _so = (unsigned)(((size_t)(br) * K + (size_t)(kt) * BK) * 2); \
    __builtin_amdgcn_raw_ptr_buffer_load_lds(RS, (__attribute__((address_space(3))) void*)((char*)(P) + tid * 16), 16, goff0, _so, 0, 0); \
    __builtin_amdgcn_raw_ptr_buffer_load_lds(RS, (__attribute__((address_space(3))) void*)((char*)(P) + tid * 16 + 8192), 16, goff1, _so, 0, 0); } while (0)
#define LDA(dst, b, h) for (int m = 0; m < 4; ++m) for (int k = 0; k < 2; ++k) \
    dst[m][k] = *reinterpret_cast<const bf16x8*>((char*)SA(b, h) + lds_byte(wr * 64 + m * 16 + fr, k * 32 + fq * 8))
#define LDB(dst, b, h) for (int n = 0; n < 2; ++n) for (int k = 0; k < 2; ++k) \
    dst[n][k] = *reinterpret_cast<const bf16x8*>((char*)SB(b, h) + lds_byte(wc * 32 + n * 16 + fr, k * 32 + fq * 8))
#define MMA(ai, bj, At, Bt_) do { __builtin_amdgcn_s_setprio(1); \
    for (int m = 0; m < 4; ++m) for (int n = 0; n < 2; ++n) for (int k = 0; k < 2; ++k) \
      acc[ai][bj][m][n] = __builtin_amdgcn_mfma_f32_16x16x32_bf16(Bt_[n][k], At[m][k], acc[ai][bj][m][n], 0, 0, 0); \
    __builtin_amdgcn_s_setprio(0); } while (0)
#define WAIT_V(n) asm volatile("s_waitcnt vmcnt(" #n ")" ::: "memory")
#define WAIT_L(n) asm volatile("s_waitcnt lgkmcnt(" #n ")" ::: "memory")
#define BAR __builtin_amdgcn_s_barrier()
#define SCHED __builtin_amdgcn_sched_barrier(0)
    const int tid = tidx(), G = gdim(), bid = (bidx() + rot) % G;
    const int nM = M / BM, nN = N / BM, nwg = nM * nN;
    const int wid = tid >> 6, lane = tid & 63, wr = wid >> 2, wc = wid & 3, fr = lane & 15, fq = lane >> 4;
    const int nt = K / BK;
    unsigned goff0, goff1;
    const __amdgpu_buffer_rsrc_t rsA = __builtin_amdgcn_make_buffer_rsrc((void*)A, (short)0, 0x7fffffff, 0x00020000);
    const __amdgpu_buffer_rsrc_t rsB = __builtin_amdgcn_make_buffer_rsrc((void*)Bt, (short)0, 0x7fffffff, 0x00020000);
    { int r_, c_; stage_rc(tid * 16, r_, c_); goff0 = (unsigned)(r_ * K + c_) * 2u; stage_rc(tid * 16 + 8192, r_, c_); goff1 = (unsigned)(r_ * K + c_) * 2u; }
    for (int round = 0;; ++round) {
        const int L = round * G + bid;
        if (L >= nwg) break;
        int wgid = L;
        { const int q = nwg / NXCD, r = nwg % NXCD, xcd = wgid % NXCD, off = wgid / NXCD; wgid = (xcd < r ? xcd * (q + 1) : r * (q + 1) + (xcd - r) * q) + off; }
        const int nig = WGM * nN, gid = wgid / nig, fm = gid * WGM, gsz = min(nM - fm, WGM);
        const int pm = fm + ((wgid % nig) % gsz), pn = (wgid % nig) / gsz, brow = pm * BM, bcol = pn * BM;
        f32x4 acc[2][2][4][2] = {};
        bf16x8 At[4][2], B0[2][2], B1[2][2];
        WAIT_V(0);
        STAGE(SB(0, 0), rsB, bcol, 0); STAGE(SA(0, 0), rsA, brow, 0);
        STAGE(SB(0, 1), rsB, bcol + HALF, 0); STAGE(SA(0, 1), rsA, brow + HALF, 0);
        if (wr == 1) BAR;
        WAIT_V(4); BAR;
        STAGE(SB(1, 0), rsB, bcol, 1); STAGE(SA(1, 0), rsA, brow, 1); STAGE(SB(1, 1), rsB, bcol + HALF, 1);
        WAIT_V(6); BAR;
        for (int t = 0; t < nt - 2; t += 2) {
            LDB(B0, 0, 0); SCHED; LDA(At, 0, 0); STAGE(SA(1, 1), rsA, brow + HALF, t + 1);
            WAIT_L(8); BAR; WAIT_L(0); MMA(0, 0, At, B0); BAR; SCHED;
            LDB(B1, 0, 1); STAGE(SB(0, 0), rsB, bcol, t + 2);
            BAR; WAIT_L(0); MMA(0, 1, At, B1); BAR;
            LDA(At, 0, 1); STAGE(SA(0, 0), rsA, brow, t + 2);
            BAR; WAIT_L(0); MMA(1, 0, At, B0); BAR; SCHED;
            STAGE(SB(0, 1), rsB, bcol + HALF, t + 2);
            WAIT_V(6); BAR; MMA(1, 1, At, B1); BAR;
            LDB(B0, 1, 0); SCHED; LDA(At, 1, 0); STAGE(SA(0, 1), rsA, brow + HALF, t + 2);
            WAIT_L(8); BAR; WAIT_L(0); MMA(0, 0, At, B0); BAR; SCHED;
            LDB(B1, 1, 1); STAGE(SB(1, 0), rsB, bcol, t + 3);
            BAR; WAIT_L(0); MMA(0, 1, At, B1); BAR;
            LDA(At, 1, 1); STAGE(SA(1, 0), rsA, brow, t + 3);
            BAR; WAIT_L(0); MMA(1, 0, At, B0); BAR; SCHED;
            STAGE(SB(1, 1), rsB, bcol + HALF, t + 3);
            WAIT_V(6); BAR; MMA(1, 1, At, B1); BAR;
        }
        { LDB(B0, 0, 0); LDA(At, 0, 0); STAGE(SA(1, 1), rsA, brow + HALF, nt - 1);
          BAR; WAIT_L(0); MMA(0, 0, At, B0); BAR;
          LDB(B1, 0, 1); BAR; WAIT_L(0); MMA(0, 1, At, B1); BAR;
          LDA(At, 0, 1); WAIT_V(4); BAR; WAIT_L(0); MMA(1, 0, At, B0); MMA(1, 1, At, B1); BAR; }
        { LDB(B0, 1, 0); LDA(At, 1, 0); WAIT_V(2); BAR; WAIT_L(0); MMA(0, 0, At, B0); BAR;
          LDB(B1, 1, 1); WAIT_V(0); BAR; WAIT_L(0); MMA(0, 1, At, B1); BAR;
          LDA(At, 1, 1); BAR; WAIT_L(0); MMA(1, 0, At, B0); MMA(1, 1, At, B1); BAR; }
        if (wr == 0) BAR;
        __syncthreads();
#pragma unroll
        for (int ai = 0; ai < 2; ++ai)
#pragma unroll
            for (int bj = 0; bj < 2; ++bj) {
#pragma unroll
                for (int m = 0; m < 4; ++m)
#pragma unroll
                    for (int n = 0; n < 2; ++n)
                        *(f32x4*)(Cs + (wr * 64 + m * 16 + fr) * LDC + wc * 32 + n * 16 + fq * 4) = acc[ai][bj][m][n];
                __syncthreads();
                gemm_epilogue<MODE>(Cs, brow + ai * 128, bcol + bj * 128, ep);
                __syncthreads();
            }
    }
#undef SA
#undef SB
#undef STAGE
#undef LDA
#undef LDB
#undef MMA
#undef WAIT_V
#undef WAIT_L
#undef BAR
#undef SCHED
}

DI void gemm_small(const bf16_t* __restrict__ A, const bf16_t* __restrict__ Bt, int K, bf16_t* __restrict__ Yo) {
    const int tid = tidx(), lane = tid & 63, wave = tid >> 6, fr = lane & 15, g = lane >> 4;
    for (int t = bidx(); t < 256; t += gdim()) {
        const int row = MP + (t >> 4) * 32 + (wave >> 2) * 16, col = (t & 15) * 64 + (wave & 3) * 16;
        const bf16_t* ap = A + (size_t)(row + fr) * K + 8 * g;
        const bf16_t* bp = Bt + (size_t)(col + fr) * K + 8 * g;
        f32x4 acc = (f32x4){0.f, 0.f, 0.f, 0.f};
        for (int k0 = 0; k0 < K; k0 += 256) {
            uint4 av[8], bv[8];
#pragma unroll
            for (int j = 0; j < 8; ++j) { av[j] = *(const uint4*)(ap + k0 + 32 * j); bv[j] = *(const uint4*)(bp + k0 + 32 * j); }
#pragma unroll
            for (int j = 0; j < 8; ++j) acc = MFMA16(asbf(av[j]), asbf(bv[j]), acc);
        }
#pragma unroll
        for (int e = 0; e < 4; ++e) Yo[(size_t)(row + 4 * g + e) * 1024 + col + fr] = f2bf(acc[e]);
    }
}

DI void ffn_fixup(const Params& p, int layer) {
    const float* HALO = (const float*)(p.ws + WS_HALO); const float* HG = (const float*)(p.ws + WS_HEADG); const float* HU = (const float*)(p.ws + WS_HEADU);
    bf16_t* ACT = (bf16_t*)(p.ws + WS_R1);
    const float* cw = p.in[22] + (size_t)layer * 3 * 2816;
    const size_t gt = (size_t)bidx() * NT + tidx(), gn = (size_t)gdim() * NT;
    for (size_t i = gt; i < (size_t)256 * 2 * 352; i += gn) {
        const int c = (int)(i % 352) * 8, ri = (int)((i / 352) & 1), mt = (int)(i / 704);
        if ((mt & 63) == 0) continue;
        const F8 w0 = ldf8(cw + c), w1 = ldf8(cw + 2816 + c), w2 = ldf8(cw + 5632 + c);
        F8 g0, g1, g2;
        if (ri == 0) { g0 = ldf8(HG + ((size_t)mt * 2) * 2816 + c); g1 = ldf8(HALO + ((size_t)(mt - 1) * 2 + 1) * 2816 + c); g2 = ldf8(HALO + ((size_t)(mt - 1) * 2) * 2816 + c); }
        else { g0 = ldf8(HG + ((size_t)mt * 2 + 1) * 2816 + c); g1 = ldf8(HG + ((size_t)mt * 2) * 2816 + c); g2 = ldf8(HALO + ((size_t)(mt - 1) * 2 + 1) * 2816 + c); }
        const F8 up = ldf8(HU + ((size_t)mt * 2 + ri) * 2816 + c);
        F8 o;
#pragma unroll
        for (int e = 0; e < 8; ++e) o.v[e] = siluf(w0.v[e] * g2.v[e] + w1.v[e] * g1.v[e] + w2.v[e] * g0.v[e]) * up.v[e];
        stb8(ACT + ((size_t)mt * 128 + ri) * 2816 + c, o);
    }
}

DI void ln_phase(const Params& p, const bf16_t* __restrict__ Y, const float* __restrict__ g, const float* __restrict__ b, bool final_out) {
    bf16_t* XB = (bf16_t*)(p.ws + WS_XB);
    const int lane = tidx() & 63, gw = (bidx() * NT + tidx()) >> 6, nw = (gdim() * NT) >> 6;
    F8 gg[2], bb[2];
#pragma unroll
    for (int it = 0; it < 2; ++it) { gg[it] = ldf8(g + it * 512 + lane * 8); bb[it] = ldf8(b + it * 512 + lane * 8); }
    for (int r0 = gw; r0 < MT; r0 += 2 * nw) {
        const int r1 = r0 + nw; const bool two = r1 < MT; const int rr[2] = {r0, two ? r1 : r0};
        uint4 xr[2][2], yr[2][2];
#pragma unroll
        for (int q = 0; q < 2; ++q)
#pragma unroll
            for (int it = 0; it < 2; ++it) { const size_t off = (size_t)rr[q] * 1024 + it * 512 + lane * 8; xr[q][it] = *(const uint4*)(XB + off); yr[q][it] = *(const uint4*)(Y + off); }
        float v[2][16];
#pragma unroll
        for (int q = 0; q < 2; ++q)
#pragma unroll
            for (int it = 0; it < 2; ++it) { const F8 x = unpack8(xr[q][it]), y = unpack8(yr[q][it]);
#pragma unroll
                for (int e = 0; e < 8; ++e) v[q][it * 8 + e] = ALPHA * x.v[e] + y.v[e]; }
        float s0 = 0.f, s1 = 0.f;
#pragma unroll
        for (int e = 0; e < 16; ++e) { s0 += v[0][e]; s1 += v[1][e]; }
        const float mu0 = wsum(s0) * (1.f / 1024.f), mu1 = wsum(s1) * (1.f / 1024.f);
        float q0 = 0.f, q1 = 0.f;
#pragma unroll
        for (int e = 0; e < 16; ++e) { const float d0 = v[0][e] - mu0, d1 = v[1][e] - mu1; q0 += d0 * d0; q1 += d1 * d1; }
        const float rs0 = rsqrtf(wsum(q0) * (1.f / 1024.f) + EPS), rs1 = rsqrtf(wsum(q1) * (1.f / 1024.f) + EPS);
#pragma unroll
        for (int q = 0; q < 2; ++q) {
            if (q == 1 && !two) break;
            const float mu = q ? mu1 : mu0, rs = q ? rs1 : rs0;
#pragma unroll
            for (int it = 0; it < 2; ++it) {
                const int c = it * 512 + lane * 8;
                F8 o;
#pragma unroll
                for (int e = 0; e < 8; ++e) o.v[e] = (v[q][it * 8 + e] - mu) * rs * gg[it].v[e] + bb[it].v[e];
                if (final_out) stf8(p.out + (size_t)rr[q] * 1024 + c, o);
                else stb8(XB + (size_t)rr[q] * 1024 + c, o);
            }
        }
    }
}

DI void even_elem(const Params& p, int e) {
    const bf16_t* H1 = (const bf16_t*)(p.ws + WS_R1);
    bf16_t* QN = (bf16_t*)(p.ws + WS_R1 + (size_t)MT * 2304 * 2);
    bf16_t* LAT = QN + (size_t)MT * 384;
    bf16_t* KB = (bf16_t*)(p.ws + WS_R2 + (size_t)MT * 768 * 2);
    bf16_t* CAT = (bf16_t*)p.out;
    const float2* ROPE = (const float2*)(p.ws + WS_ROPE);
    const float* gq = p.in[9] + e * 384; const float* gkv = p.in[10] + e * 256; const float* scw = p.in[13] + e * 3 * 512;
    const int lane = tidx() & 63, gw = (bidx() * NT + tidx()) >> 6, nw = (gdim() * NT) >> 6;
    {
        const int lq = lane < 48 ? lane : 47, lk = lane < 32 ? lane : 31, lr = lane < 2 ? lane : 1;
        const F8 gqv = ldf8(gq + lq * 8), gkvv = ldf8(gkv + lk * 8);
        for (int ra = gw; ra < MT; ra += 2 * nw) {
            const bool two = ra + nw < MT; const int rr[2] = {ra, two ? ra + nw : ra};
            uint4 xq[2], xkv[2], x1[2], x2[2];
#pragma unroll
            for (int q = 0; q < 2; ++q) { const bf16_t* hr = H1 + (size_t)rr[q] * 2304;
                xq[q] = *(const uint4*)(hr + lq * 8); xkv[q] = *(const uint4*)(hr + 384 + lk * 8); x1[q] = *(const uint4*)(hr + 640 + lr * 8); x2[q] = *(const uint4*)(hr + 656 + lr * 8); }
#pragma unroll
            for (int q = 0; q < 2; ++q) {
                if (q == 1 && !two) break;
                const int r = rr[q]; int sq, pos, len; rowinfo(r, sq, pos, len);
                const int kvr = kvrow_of(r), apos = sq >= 4 ? pos + 2048 : pos;
                { F8 x = unpack8(xq[q]); float ss = 0.f;
                  if (lane < 48) { for (int k = 0; k < 8; ++k) ss += x.v[k] * x.v[k]; }
                  const float rs = rsqrtf(wsum(ss) * (1.f / 384.f) + EPS);
                  if (lane < 48) { for (int k = 0; k < 8; ++k) x.v[k] *= rs * gqv.v[k]; stb8(QN + (size_t)r * 384 + lane * 8, x); } }
                { F8 x = unpack8(xkv[q]); float ss = 0.f;
                  if (lane < 32) { for (int k = 0; k < 8; ++k) ss += x.v[k] * x.v[k]; }
                  const float rs = rsqrtf(wsum(ss) * (1.f / 256.f) + EPS);
                  if (lane < 32) { for (int k = 0; k < 8; ++k) x.v[k] *= rs * gkvv.v[k];
                      float* lo = sq < 4 ? p.out + O_PLAT + (((size_t)e * 4 + sq) * 8192 + pos) * 256 : p.out + O_SLAT + (((size_t)e * 8 + (sq - 4)) * 64 + pos) * 256;
                      stf8(lo + lane * 8, x); stb8(LAT + (size_t)kvr * 256 + lane * 8, x); } }
                if (lane < 2) {
                    const F8 a1 = unpack8(x1[q]), a2 = unpack8(x2[q]);
                    F8 o1, o2; const float2* rp = ROPE + apos * 16 + lane * 8;
#pragma unroll
                    for (int k = 0; k < 8; ++k) { const float2 cs = rp[k]; o1.v[k] = a1.v[k] * cs.x - a2.v[k] * cs.y; o2.v[k] = a2.v[k] * cs.x + a1.v[k] * cs.y; }
                    float* ko = sq < 4 ? p.out + O_PKR + (((size_t)e * 4 + sq) * 8192 + pos) * 32 : p.out + O_SKR + (((size_t)e * 8 + (sq - 4)) * 64 + pos) * 32;
                    stf8(ko + lane * 8, o1); stf8(ko + 16 + lane * 8, o2);
#pragma unroll
                    for (int h = 0; h < 8; ++h) { stb8(KB + (size_t)kvr * 768 + h * 96 + 64 + lane * 8, o1); stb8(KB + (size_t)kvr * 768 + h * 96 + 80 + lane * 8, o2); }
                }
            }
        }
    }
    {
        const int c = lane * 8;
        const F8 w0 = ldf8(scw + c), w1 = ldf8(scw + 512 + c), w2 = ldf8(scw + 1024 + c);
        for (int ck = gw; ck < MT / 8; ck += nw) {
            const int r0 = ck * 8; int sq, pos0, len; rowinfo(r0, sq, pos0, len);
            const bf16_t* hp = H1 + (size_t)r0 * 2304 + c;
            uint4 gbr[8], gcr[8], shr[8];
#pragma unroll
            for (int t = 0; t < 8; ++t) { gbr[t] = *(const uint4*)(hp + (size_t)t * 2304 + 672); gcr[t] = *(const uint4*)(hp + (size_t)t * 2304 + 1184); shr[t] = *(const uint4*)(hp + (size_t)t * 2304 + 1696); }
            F8 a1, a2;
            if (pos0 > 0) { const F8 u1 = ldb8(hp - 2304 + 1184), v1 = ldb8(hp - 2304 + 1696), u2 = ldb8(hp - 4608 + 1184), v2 = ldb8(hp - 4608 + 1696);
                            for (int k = 0; k < 8; ++k) { a1.v[k] = u1.v[k] * v1.v[k]; a2.v[k] = u2.v[k] * v2.v[k]; } }
            else if (sq >= 4) { const float* hist = p.in[4] + ((size_t)e * 8 + (sq - 4)) * 2 * 512 + c; a1 = ldf8(hist + 512); a2 = ldf8(hist); }
            else { for (int k = 0; k < 8; ++k) { a1.v[k] = 0.f; a2.v[k] = 0.f; } }
            const bool last = (pos0 + 8 == len);
#pragma unroll
            for (int t = 0; t < 8; ++t) {
                const F8 gb = unpack8(gbr[t]), gc = unpack8(gcr[t]), sh = unpack8(shr[t]);
                F8 a0, o;
#pragma unroll
                for (int k = 0; k < 8; ++k) { a0.v[k] = gc.v[k] * sh.v[k]; o.v[k] = gb.v[k] * (w0.v[k] * a2.v[k] + w1.v[k] * a1.v[k] + w2.v[k] * a0.v[k]); }
                stb8(CAT + (size_t)(r0 + t) * 1024 + 512 + c, o);
                if (last && t >= 6) {
                    float* so = sq < 4 ? p.out + O_PSC + (((size_t)e * 4 + sq) * 2 + (t - 6)) * 512 : p.out + O_SSC + (((size_t)e * 8 + (sq - 4)) * 2 + (t - 6)) * 512;
                    stf8(so + c, a0);
                }
                a2 = a1; a1 = a0;
            }
        }
    }
}

DI void even_pastcopy(const Params& p, int e, int vb, int nb) {
    bf16_t* LAT = (bf16_t*)(p.ws + WS_R1 + (size_t)MT * 2304 * 2) + (size_t)MT * 384;
    bf16_t* KB = (bf16_t*)(p.ws + WS_R2 + (size_t)MT * 768 * 2);
    const int lane = tidx() & 63, gw = vb * (NT / 64) + (tidx() >> 6), nw = nb * (NT / 64);
    for (int j0 = gw; j0 < 8 * 2048; j0 += 4 * nw) {
        F8 v[4];
#pragma unroll
        for (int q = 0; q < 4; ++q) {
            const int j = j0 + q * nw < 8 * 2048 ? j0 + q * nw : j0, s = j >> 11, t = j & 2047;
            v[q] = lane < 32 ? ldf8(p.in[2] + (((size_t)e * 8 + s) * 2048 + t) * 256 + lane * 8)
                             : ldf8(p.in[3] + (((size_t)e * 8 + s) * 2048 + t) * 32 + ((lane - 32) & 3) * 8);
        }
#pragma unroll
        for (int q = 0; q < 4; ++q) {
            const int j = j0 + q * nw; if (j >= 8 * 2048) break;
            const int s = j >> 11, t = j & 2047, kvr = MP + s * 2112 + t;
            if (lane < 32) stb8(LAT + (size_t)kvr * 256 + lane * 8, v[q]);
            else { const int h = (lane - 32) >> 2, cc = ((lane - 32) & 3) * 8; stb8(KB + (size_t)kvr * 768 + h * 96 + 64 + cc, v[q]); }
        }
    }
}

DI void attn_phase(const Params& p, unsigned char* smem) {
    const bf16_t* Q = (const bf16_t*)(p.ws + WS_R2);
    const bf16_t* KB = Q + (size_t)MT * 768;
    const bf16_t* VT = KB + (size_t)KVROWS * 768;
    bf16_t* CAT = (bf16_t*)p.out;
    const int tid = tidx(), lane = tid & 63, wave = tid >> 6, fr = lane & 15, g = lane >> 4;
    constexpr int KST = 112, VST = 136, BUF = 128 * KST + 64 * VST;
    bf16_t* sbuf = (bf16_t*)smem;
    const int G = gdim();
    for (int i = 0; i * G < 1088; ++i) {
        const int idx = (i & 1) ? (i * G + (G - 1 - bidx())) : (i * G + bidx());
        if (idx >= 1088) continue;
        int h, qrow0, kvbase, ntiles, Ts, wtiles; size_t vb;
        if (idx < 1024) { const int jt = 31 - (idx >> 5), bh = idx & 31, b = bh >> 3; h = bh & 7; qrow0 = b * 8192 + jt * 256; kvbase = b * 8192; ntiles = 4 * jt + 4;
                          vb = (size_t)b * (512 * 8192); Ts = 8192; wtiles = 4 * jt + 1 + (wave >> 1); }
        else { const int u = idx - 1024, s = u >> 3; h = u & 7; qrow0 = MP + 64 * s; kvbase = MP + s * 2112; ntiles = 33;
               vb = (size_t)4 * 512 * 8192 + (size_t)s * (512 * 2112); Ts = 2112; wtiles = wave < 2 ? 33 : 0; }
        bf16x8 qf[2][3];
#pragma unroll
        for (int qs = 0; qs < 2; ++qs)
#pragma unroll
            for (int s = 0; s < 3; ++s) {
                uint4 u = make_uint4(0, 0, 0, 0);
                if (wtiles > 0) u = *(const uint4*)(Q + (size_t)(qrow0 + 32 * wave + 16 * qs + fr) * 768 + h * 96 + 32 * s + 8 * g);
                qf[qs][s] = asbf(u);
            }
        f32x4 ot[4][2];
#pragma unroll
        for (int a = 0; a < 4; ++a)
#pragma unroll
            for (int b = 0; b < 2; ++b) ot[a][b] = (f32x4){0.f, 0.f, 0.f, 0.f};
        float mrow[2] = {0.f, 0.f}, lrow[2] = {0.f, 0.f};
        const int kr0 = tid / 12, kr1 = (tid + 512) / 12, kr2 = (tid + 1024) / 12;
        const int kh0 = tid - kr0 * 12, kh1 = tid + 512 - kr1 * 12, kh2 = tid + 1024 - kr2 * 12;
        const int kd0 = kr0 * KST + kh0 * 8, kd1 = kr1 * KST + kh1 * 8, kd2 = kr2 * KST + kh2 * 8;
        const int ko0 = kr0 * 768 + kh0 * 8, ko1 = kr1 * 768 + kh1 * 8, ko2 = kr2 * 768 + kh2 * 8;
        const bf16_t* kbase = KB + (size_t)kvbase * 768 + h * 96;
        const int vch = tid & 15, vdv0 = tid >> 4, vdv1 = vdv0 + 32;
        const int vd0 = 128 * KST + vdv0 * VST + vch * 8, vd1 = 128 * KST + vdv1 * VST + vch * 8;
        const bf16_t* vbase = VT + vb + (size_t)(h * 64) * Ts + vch * 8;
        const size_t vo0 = (size_t)vdv0 * Ts, vo1 = (size_t)vdv1 * Ts;
        const int nst = (ntiles + 1) >> 1;
        unsigned zz = 0; asm volatile("" : "+v"(zz));
        uint4 rk0, rk1 = make_uint4(zz, zz, zz, zz), rk2 = rk1, rv0 = rk1, rv1 = rk1;
        { const bool h2 = 1 < ntiles;
          rk0 = *(const uint4*)(kbase + ko0);
          if (kr1 < 64 || h2) rk1 = *(const uint4*)(kbase + ko1);
          if (h2) rk2 = *(const uint4*)(kbase + ko2);
          if (vch < 8 || h2) { rv0 = *(const uint4*)(vbase + vo0); rv1 = *(const uint4*)(vbase + vo1); } }
        *(uint4*)(sbuf + kd0) = rk0; *(uint4*)(sbuf + kd1) = rk1; *(uint4*)(sbuf + kd2) = rk2;
        *(uint4*)(sbuf + vd0) = rv0; *(uint4*)(sbuf + vd1) = rv1;
        __syncthreads();
        for (int st_ = 0; st_ < nst; ++st_) {
            const int cur = st_ & 1;
            if (st_ + 1 < nst) {
                const bool h2 = 2 * st_ + 3 < ntiles;
                const bf16_t* kb2 = kbase + (size_t)(st_ + 1) * 128 * 768; const bf16_t* vb2 = vbase + (st_ + 1) * 128;
                rk0 = *(const uint4*)(kb2 + ko0);
                if (kr1 < 64 || h2) rk1 = *(const uint4*)(kb2 + ko1);
                if (h2) rk2 = *(const uint4*)(kb2 + ko2);
                if (vch < 8 || h2) { rv0 = *(const uint4*)(vb2 + vo0); rv1 = *(const uint4*)(vb2 + vo1); }
            }
#pragma unroll
            for (int hf = 0; hf < 2; ++hf) {
                if (2 * st_ + hf < wtiles) {
                    const bf16_t* sK = sbuf + cur * BUF + hf * 64 * KST; const bf16_t* sV = sbuf + cur * BUF + 128 * KST + hf * 64;
                    bf16x8 kf[4][3];
#pragma unroll
                    for (int kk = 0; kk < 4; ++kk)
#pragma unroll
                        for (int s = 0; s < 3; ++s) kf[kk][s] = *(const bf16x8*)(sK + (16 * kk + fr) * KST + 32 * s + 8 * g);
#pragma unroll
                    for (int qs = 0; qs < 2; ++qs) {
                        f32x4 st[4];
                        const float nm = -mrow[qs];
#pragma unroll
                        for (int kk = 0; kk < 4; ++kk) {
                            st[kk] = (f32x4){nm, nm, nm, nm};
#pragma unroll
                            for (int s = 0; s < 3; ++s) st[kk] = MFMA16(kf[kk][s], qf[qs][s], st[kk]);
                        }
                        float mx = fmaxf(fmaxf(st[0][0], st[0][1]), fmaxf(st[0][2], st[0][3]));
#pragma unroll
                        for (int kk = 1; kk < 4; ++kk) mx = fmaxf(mx, fmaxf(fmaxf(st[kk][0], st[kk][1]), fmaxf(st[kk][2], st[kk][3])));
                        const bool first = (st_ == 0 && hf == 0);
                        if (first || __any(mx > 6.f)) {
                            mx = fmaxf(mx, __shfl_xor(mx, 16)); mx = fmaxf(mx, __shfl_xor(mx, 32));
                            const float shift = first ? mx : fmaxf(mx, 0.f);
                            const float al = first ? 1.f : __builtin_amdgcn_exp2f(-shift);
                            mrow[qs] += shift; lrow[qs] *= al;
#pragma unroll
                            for (int dt = 0; dt < 4; ++dt) ot[dt][qs] *= al;
#pragma unroll
                            for (int kk = 0; kk < 4; ++kk)
#pragma unroll
                                for (int e = 0; e < 4; ++e) st[kk][e] -= shift;
                        }
                        float rs = 0.f;
#pragma unroll
                        for (int kk = 0; kk < 4; ++kk)
#pragma unroll
                            for (int e = 0; e < 4; ++e) { const float pv = __builtin_amdgcn_exp2f(st[kk][e]); st[kk][e] = pv; rs += pv; }
                        lrow[qs] += rs;
#pragma unroll
                        for (int s2 = 0; s2 < 2; ++s2) {
                            uint4 u; u.x = pack2(st[2 * s2][0], st[2 * s2][1]); u.y = pack2(st[2 * s2][2], st[2 * s2][3]);
                            u.z = pack2(st[2 * s2 + 1][0], st[2 * s2 + 1][1]); u.w = pack2(st[2 * s2 + 1][2], st[2 * s2 + 1][3]);
                            const bf16x8 pf = asbf(u);
#pragma unroll
                            for (int dt = 0; dt < 4; ++dt) {
                                const uint2 a = *(const uint2*)(sV + (16 * dt + fr) * VST + 32 * s2 + 4 * g), b = *(const uint2*)(sV + (16 * dt + fr) * VST + 32 * s2 + 16 + 4 * g);
                                ot[dt][qs] = MFMA16(asbf(make_uint4(a.x, a.y, b.x, b.y)), pf, ot[dt][qs]);
                            }
                        }
                    }
                }
            }
            if (st_ + 1 < nst) {
                bf16_t* d = sbuf + (cur ^ 1) * BUF;
                *(uint4*)(d + kd0) = rk0; *(uint4*)(d + kd1) = rk1; *(uint4*)(d + kd2) = rk2;
                *(uint4*)(d + vd0) = rv0; *(uint4*)(d + vd1) = rv1;
            }
            __syncthreads();
        }
        if (wtiles > 0) {
#pragma unroll
            for (int qs = 0; qs < 2; ++qs) {
                float l = lrow[qs]; l += __shfl_xor(l, 16); l += __shfl_xor(l, 32);
                const float inv = 1.f / l;
                const int row = qrow0 + 32 * wave + 16 * qs + fr;
#pragma unroll
                for (int dt = 0; dt < 4; ++dt) {
                    uint2 o; o.x = pack2(ot[dt][qs][0] * inv, ot[dt][qs][1] * inv); o.y = pack2(ot[dt][qs][2] * inv, ot[dt][qs][3] * inv);
                    *(uint2*)(CAT + (size_t)row * 1024 + h * 64 + 16 * dt + 4 * g) = o;
                }
            }
        }
    }
}

DI void odd_elem(const Params& p, int o) {
    const bf16_t* QR = (const bf16_t*)(p.ws + WS_R1);
    bf16_t* Q2 = (bf16_t*)(p.ws + WS_R2);
    const float* ABF = (const float*)(p.ws + WS_ABF);
    float* GB = (float*)(p.ws + WS_GB);
    const float* cw = p.in[16] + (size_t)o * 4 * 3072;
    const int lane = tidx() & 63, gw = (bidx() * NT + tidx()) >> 6, nw = (gdim() * NT) >> 6;
    for (int item = gw; item < 2080 * 6; item += nw) {
        const int chunk = item / 6, gi = item - chunk * 6, r0 = chunk * 16, c = gi * 512 + lane * 8;
        int sq, pos0, len; rowinfo(r0, sq, pos0, len);
        const bf16_t* xp = QR + (size_t)r0 * 3072 + c;
        uint4 xr[16];
#pragma unroll
        for (int t = 0; t < 16; ++t) xr[t] = *(const uint4*)(xp + (size_t)t * 3072);
        F8 h1, h2, h3;
        if (pos0 > 0) { h1 = ldb8(xp - 3072); h2 = ldb8(xp - 2 * 3072); h3 = ldb8(xp - 3 * 3072); }
        else if (sq >= 4) { const float* hist = p.in[5] + ((size_t)o * 8 + (sq - 4)) * 3 * 3072 + c; h1 = ldf8(hist + 2 * 3072); h2 = ldf8(hist + 3072); h3 = ldf8(hist); }
        else { for (int k = 0; k < 8; ++k) { h1.v[k] = 0.f; h2.v[k] = 0.f; h3.v[k] = 0.f; } }
        const F8 w0 = ldf8(cw + c), w1 = ldf8(cw + 3072 + c), w2 = ldf8(cw + 2 * 3072 + c), w3 = ldf8(cw + 3 * 3072 + c);
        const bool last = (pos0 + 16 == len);
        const float nsc = gi < 2 ? 0.08838834764831845f : 1.f;
#pragma unroll
        for (int t = 0; t < 16; ++t) {
            const F8 x0 = unpack8(xr[t]);
            F8 acc; float ss = 0.f;
#pragma unroll
            for (int k = 0; k < 8; ++k) { const float a = w3.v[k] * x0.v[k] + w2.v[k] * h1.v[k] + w1.v[k] * h2.v[k] + w0.v[k] * h3.v[k]; acc.v[k] = siluf(a); ss += acc.v[k] * acc.v[k]; }
            if (gi < 4) {
                const float rs = rsqrtf(gsum16(ss) + EPS) * nsc;
#pragma unroll
                for (int k = 0; k < 8; ++k) acc.v[k] *= rs;
            }
            stb8(Q2 + (size_t)(r0 + t) * 3072 + c, acc);
            if (last && t >= 13) {
                float* so = sq < 4 ? p.out + O_PDC + (((size_t)o * 4 + sq) * 3 + (t - 13)) * 3072 : p.out + O_SDC + (((size_t)o * 8 + (sq - 4)) * 3 + (t - 13)) * 3072;
                stf8(so + c, x0);
            }
            h3 = h2; h2 = h1; h1 = x0;
        }
        if (gi == 0) {
#pragma unroll
            for (int k = 0; k < 2; ++k) {
                const int pi = lane + 64 * k, r = r0 + (pi >> 3), hd = pi & 7;
                const float a = ABF[(size_t)r * 16 + hd], bt = ABF[(size_t)r * 16 + 8 + hd];
                const float xx = a + p.in[18][o * 8 + hd];
                const float ey = __expf(xx);
                const float sp = xx > 20.f ? xx : (ey < 0.01f ? ey * (1.f - ey * (0.5f - ey * (1.f / 3.f))) : __logf(1.f + ey));
                GB[(size_t)r * 16 + hd] = -__expf(p.in[17][o * 8 + hd]) * sp;
                GB[(size_t)r * 16 + 8 + hd] = 1.f / (1.f + __expf(-bt));
            }
        }
    }
}

constexpr int MST = 68;
DI void delta_prep(const Params& p, unsigned char* smem) {
    const bf16_t* Q2 = (const bf16_t*)(p.ws + WS_R2);
    const float* GB = (const float*)(p.ws + WS_GB);
    bf16_t* TB = (bf16_t*)(p.ws + WS_R1 + (size_t)MT * 1024 * 2);
    bf16_t* ATB = TB + (size_t)4160 * 4096;
    float* SCB = (float*)(ATB + (size_t)4160 * 4096);
    const int tid = tidx(), lane = tid & 63, wave = tid >> 6, fr = lane & 15, g = lane >> 4;
    float* Ms = (float*)smem + wave * (64 * MST + 128);
    float* sG = Ms + 64 * MST; float* sBt = sG + 64;
    for (int base = bidx() * 8; base < 4160; base += gdim() * 8) {
        const int u = base + wave, c = u >> 3, h = u & 7, r0 = c * 64;
        float Gv = GB[(size_t)(r0 + lane) * 16 + h];
        const float beta = GB[(size_t)(r0 + lane) * 16 + 8 + h];
#pragma unroll
        for (int off = 1; off < 64; off <<= 1) { const float t = __shfl_up(Gv, off); if (lane >= off) Gv += t; }
        sG[lane] = Gv; sBt[lane] = beta;
        { const float gl = __shfl(Gv, 63), eg = __expf(Gv);
          float* sc = SCB + (size_t)u * 256;
          sc[lane] = beta * eg; sc[64 + lane] = eg; sc[128 + lane] = __expf(gl - Gv); sc[192 + lane] = beta; }
        asm volatile("s_waitcnt lgkmcnt(0)" ::: "memory");
        const bf16_t* kbp = Q2 + (size_t)(r0 + fr) * 3072 + 1024 + h * 128 + 8 * g;
        const bf16_t* qbp = Q2 + (size_t)(r0 + fr) * 3072 + h * 128 + 8 * g;
        bf16_t* ao = ATB + (size_t)u * 4096;
#pragma unroll
        for (int it = 0; it < 4; ++it) {
            bf16x8 qf[4], ki[4];
#pragma unroll
            for (int s = 0; s < 4; ++s) { qf[s] = asbf(*(const uint4*)(qbp + (size_t)16 * it * 3072 + 32 * s)); ki[s] = asbf(*(const uint4*)(kbp + (size_t)16 * it * 3072 + 32 * s)); }
#pragma unroll
            for (int jt = 0; jt < 4; ++jt) {
                if (jt > it) {
#pragma unroll
                    for (int e = 0; e < 4; ++e) ao[(16 * it + 4 * g + e) * 64 + 16 * jt + fr] = 0;
                    continue;
                }
                f32x4 kk = (f32x4){0.f, 0.f, 0.f, 0.f}, qk = (f32x4){0.f, 0.f, 0.f, 0.f};
#pragma unroll
                for (int s = 0; s < 4; ++s) {
                    const bf16x8 kj = asbf(*(const uint4*)(kbp + (size_t)16 * jt * 3072 + 32 * s));
                    kk = MFMA16(ki[s], kj, kk); qk = MFMA16(qf[s], kj, qk);
                }
                const int j = 16 * jt + fr; const float Gj = sG[j];
#pragma unroll
                for (int e = 0; e < 4; ++e) {
                    const int i = 16 * it + 4 * g + e;
                    const float Gi = sG[i], bi = sBt[i];
                    const float dec = (j <= i) ? __expf(Gi - Gj) : 0.f;
                    Ms[i * MST + j] = (j < i) ? bi * kk[e] * dec : 0.f;
                    ao[i * 64 + j] = f2bf(qk[e] * dec);
                }
            }
        }
        asm volatile("s_waitcnt lgkmcnt(0)" ::: "memory");
        float T[64];
#pragma unroll
        for (int i = 0; i < 64; ++i) T[i] = 0.f;
#pragma unroll
        for (int i = 0; i < 64; ++i) {
            float a = (lane == i) ? 1.f : 0.f;
#pragma unroll
            for (int j4 = 0; j4 * 4 < i; ++j4) {
                const float4 m = *(const float4*)(Ms + i * MST + 4 * j4);
                a -= m.x * T[4 * j4] + m.y * T[4 * j4 + 1] + m.z * T[4 * j4 + 2] + m.w * T[4 * j4 + 3];
            }
            T[i] = a;
        }
        bf16_t* to = TB + (size_t)u * 4096;
#pragma unroll
        for (int i = 0; i < 64; ++i) to[i * 64 + lane] = f2bf(T[i]);
        asm volatile("s_waitcnt lgkmcnt(0)" ::: "memory");
    }
}

struct ScanLd { uint4 aK[4]; uint4 aQ[4]; uint4 aT[2]; uint4 aA[2]; unsigned vv[4]; float4 scK, scQ, kt, be; float gt; };
DI void scan_load(ScanLd& L, const bf16_t* Q2, const float* SCB, const bf16_t* TB, const bf16_t* ATB, int ch, int h, int sl, int wave, int lane) {
    const int fr = lane & 15, g = lane >> 4, r0 = ch * 64, uidx = ch * 8 + h;
    const bf16_t* rowp = Q2 + (size_t)(r0 + 16 * wave + fr) * 3072 + h * 128 + 8 * g;
#pragma unroll
    for (int s = 0; s < 4; ++s) { L.aQ[s] = *(const uint4*)(rowp + 32 * s); L.aK[s] = *(const uint4*)(rowp + 1024 + 32 * s); }
#pragma unroll
    for (int s = 0; s < 2; ++s) { L.aT[s] = *(const uint4*)(TB + (size_t)uidx * 4096 + (16 * wave + fr) * 64 + 32 * s + 8 * g);
                                  L.aA[s] = *(const uint4*)(ATB + (size_t)uidx * 4096 + (16 * wave + fr) * 64 + 32 * s + 8 * g); }
#pragma unroll
    for (int e = 0; e < 4; ++e) L.vv[e] = (unsigned)Q2[(size_t)(r0 + 16 * wave + 4 * g + e) * 3072 + 2048 + h * 128 + sl * 16 + fr];
    const float* sc = SCB + (size_t)uidx * 256 + 16 * wave + 4 * g;
    L.scK = *(const float4*)(sc); L.scQ = *(const float4*)(sc + 64); L.kt = *(const float4*)(sc + 128); L.be = *(const float4*)(sc + 192);
    L.gt = SCB[(size_t)uidx * 256 + 64 + 63];
}
DI void scan_step(const ScanLd& cur, f32x4 (&S)[2], bf16_t* OB, bf16_t* sST, bf16_t* sUT, bf16_t* sVT, bf16_t* sV2, bf16_t* kT, int r0, int h, int sl, int wave, int lane) {
    const int fr = lane & 15, g = lane >> 4;
#pragma unroll
    for (int m = 0; m < 2; ++m) { uint2 w; w.x = pack2(S[m][0], S[m][1]); w.y = pack2(S[m][2], S[m][3]); *(uint2*)(sST + fr * 136 + 16 * (2 * wave + m) + 4 * g) = w; }
    asm volatile("s_waitcnt lgkmcnt(0)" ::: "memory"); __builtin_amdgcn_s_barrier(); asm volatile("" ::: "memory");
    f32x4 ks = (f32x4){0.f, 0.f, 0.f, 0.f}, oo = (f32x4){0.f, 0.f, 0.f, 0.f};
#pragma unroll
    for (int s = 0; s < 4; ++s) {
        const bf16x8 bS = *(const bf16x8*)(sST + fr * 136 + 32 * s + 8 * g);
        ks = MFMA16(asbf(cur.aK[s]), bS, ks);
        oo = MFMA16(asbf(cur.aQ[s]), bS, oo);
    }
#pragma unroll
    for (int s = 0; s < 4; ++s) {
        const uint4 kv = cur.aK[s]; const unsigned w4[4] = {kv.x, kv.y, kv.z, kv.w};
#pragma unroll
        for (int e = 0; e < 4; ++e) { kT[(32 * s + 8 * g + 2 * e) * 72 + 16 * wave + fr] = (bf16_t)(w4[e] & 0xffffu); kT[(32 * s + 8 * g + 2 * e + 1) * 72 + 16 * wave + fr] = (bf16_t)(w4[e] >> 16); }
    }
    { uint2 w; w.x = pack2(lo16(cur.vv[0]) * cur.be.x - cur.scK.x * ks[0], lo16(cur.vv[1]) * cur.be.y - cur.scK.y * ks[1]);
      w.y = pack2(lo16(cur.vv[2]) * cur.be.z - cur.scK.z * ks[2], lo16(cur.vv[3]) * cur.be.w - cur.scK.w * ks[3]);
      *(uint2*)(sUT + fr * 72 + 16 * wave + 4 * g) = w; }
    oo[0] *= cur.scQ.x; oo[1] *= cur.scQ.y; oo[2] *= cur.scQ.z; oo[3] *= cur.scQ.w;
    asm volatile("s_waitcnt lgkmcnt(0)" ::: "memory"); __builtin_amdgcn_s_barrier(); asm volatile("" ::: "memory");
    f32x4 vn = (f32x4){0.f, 0.f, 0.f, 0.f};
#pragma unroll
    for (int s = 0; s < 2; ++s) vn = MFMA16(asbf(cur.aT[s]), *(const bf16x8*)(sUT + fr * 72 + 32 * s + 8 * g), vn);
    { uint2 w; w.x = pack2(vn[0], vn[1]); w.y = pack2(vn[2], vn[3]); *(uint2*)(sVT + fr * 72 + 16 * wave + 4 * g) = w;
      uint2 w2; w2.x = pack2(vn[0] * cur.kt.x, vn[1] * cur.kt.y); w2.y = pack2(vn[2] * cur.kt.z, vn[3] * cur.kt.w); *(uint2*)(sV2 + fr * 72 + 16 * wave + 4 * g) = w2; }
    asm volatile("s_waitcnt lgkmcnt(0)" ::: "memory"); __builtin_amdgcn_s_barrier(); asm volatile("" ::: "memory");
#pragma unroll
    for (int s = 0; s < 2; ++s) oo = MFMA16(asbf(cur.aA[s]), *(const bf16x8*)(sVT + fr * 72 + 32 * s + 8 * g), oo);
#pragma unroll
    for (int e = 0; e < 4; ++e) OB[(size_t)(r0 + 16 * wave + 4 * g + e) * 1024 + h * 128 + sl * 16 + fr] = f2bf(oo[e]);
    bf16x8 b2[2];
#pragma unroll
    for (int s = 0; s < 2; ++s) b2[s] = *(const bf16x8*)(sV2 + fr * 72 + 32 * s + 8 * g);
#pragma unroll
    for (int m = 0; m < 2; ++m) {
        S[m] *= cur.gt;
#pragma unroll
        for (int s = 0; s < 2; ++s) S[m] = MFMA16(*(const bf16x8*)(kT + (16 * (2 * wave + m) + fr) * 72 + 32 * s + 8 * g), b2[s], S[m]);
    }
}
DI void delta_scan(const Params& p, int o, unsigned char* smem) {
    const bf16_t* Q2 = (const bf16_t*)(p.ws + WS_R2);
    bf16_t* OB = (bf16_t*)(p.ws + WS_R1);
    const bf16_t* TB = (const bf16_t*)(p.ws + WS_R1 + (size_t)MT * 1024 * 2);
    const bf16_t* ATB = TB + (size_t)4160 * 4096;
    const float* SCB = (const float*)(ATB + (size_t)4160 * 4096);
    const int tid = tidx(), lane = tid & 63, wave = tid >> 6, fr = lane & 15, g = lane >> 4;
    const bool act = wave < 4;
    bf16_t* sST = (bf16_t*)smem;
    bf16_t* sUT = sST + 16 * 136;
    bf16_t* sVT = sUT + 16 * 72;
    bf16_t* sV2 = sVT + 16 * 72;
    bf16_t* sKT = sV2 + 16 * 72;
    for (int u = bidx(); u < 256 + 512; u += gdim()) {
        int h, sl, c0, nsteps; const float* s_in; float* s_out;
        if (u < 256) { const int bh = (u & 7) + 8 * (u >> 6), b = bh >> 3; sl = (u >> 3) & 7; h = bh & 7; c0 = b * 128; nsteps = 128; s_in = nullptr;
                       s_out = p.out + O_PDS + (((size_t)o * 4 + b) * 8 + h) * 16384; }
        else { const int v = u - 256, s = v >> 6; h = (v >> 3) & 7; sl = v & 7; c0 = 512 + s; nsteps = 1;
               s_in = p.in[6] + (((size_t)o * 8 + s) * 8 + h) * 16384; s_out = p.out + O_SDS + (((size_t)o * 8 + s) * 8 + h) * 16384; }
        if (act) {
            f32x4 S[2];
#pragma unroll
            for (int m = 0; m < 2; ++m)
#pragma unroll
                for (int e = 0; e < 4; ++e) S[m][e] = s_in ? s_in[(size_t)(16 * (2 * wave + m) + 4 * g + e) * 128 + sl * 16 + fr] : 0.f;
            ScanLd A, B;
            const int clast = c0 + nsteps - 1;
            scan_load(A, Q2, SCB, TB, ATB, c0, h, sl, wave, lane);
            for (int n = 0; n < nsteps; n += 2) {
                scan_load(B, Q2, SCB, TB, ATB, min(c0 + n + 1, clast), h, sl, wave, lane);
                scan_step(A, S, OB, sST, sUT, sVT, sV2, sKT, (c0 + n) * 64, h, sl, wave, lane);
                if (n + 1 >= nsteps) break;
                scan_load(A, Q2, SCB, TB, ATB, min(c0 + n + 2, clast), h, sl, wave, lane);
                scan_step(B, S, OB, sST, sUT, sVT, sV2, sKT + 128 * 72, (c0 + n + 1) * 64, h, sl, wave, lane);
            }
#pragma unroll
            for (int m = 0; m < 2; ++m)
#pragma unroll
                for (int e = 0; e < 4; ++e) s_out[(size_t)(16 * (2 * wave + m) + 4 * g + e) * 128 + sl * 16 + fr] = S[m][e];
        } else {
            for (int n = 0; n < nsteps; ++n) { __builtin_amdgcn_s_barrier(); __builtin_amdgcn_s_barrier(); __builtin_amdgcn_s_barrier(); }
        }
        __syncthreads();
    }
}

DI void odd_gate(const Params& p, int o) {
    bf16_t* OB = (bf16_t*)(p.ws + WS_R1);
    const bf16_t* ZAB = (const bf16_t*)p.out;
    const float* go = p.in[19] + o * 128;
    const int lane = tidx() & 63, gw = (bidx() * NT + tidx()) >> 6, nw = (gdim() * NT) >> 6;
    for (int r = gw; r < MT; r += nw) {
#pragma unroll
        for (int it = 0; it < 2; ++it) {
            const int c = it * 512 + lane * 8;
            F8 x = ldb8(OB + (size_t)r * 1024 + c); const F8 z = ldb8(ZAB + (size_t)r * 1152 + c), gg = ldf8(go + (c & 127));
            float ss = 0.f;
            for (int k = 0; k < 8; ++k) ss += x.v[k] * x.v[k];
            const float rs = rsqrtf(gsum16(ss) * (1.f / 128.f) + EPS);
            for (int k = 0; k < 8; ++k) x.v[k] = x.v[k] * rs * gg.v[k] * siluf(z.v[k]);
            stb8(OB + (size_t)r * 1024 + c, x);
        }
    }
}

#define XB_TMO      128
#define XB_XCNT(j)  (256  + 64 * (j))
#define XB_XSUB(j)  (1280 + 64 * (j))
#define XB_XGEN(j)  (2304 + 64 * (j))
#define XB_TOP      3328
#define XB_TOPGEN   3392
#define XCD_BAR_WORDS 3456
#define XB_SPIN_CAP (1u << 18)
#define LAS __attribute__((address_space(3)))
constexpr size_t WS_XBAR = WS_R1 - 16384;
DI unsigned xb_ld(unsigned* p)              { return __hip_atomic_load(p, __ATOMIC_RELAXED, __HIP_MEMORY_SCOPE_AGENT); }
DI unsigned xb_add(unsigned* p, unsigned v) { return __hip_atomic_fetch_add(p, v, __ATOMIC_RELAXED, __HIP_MEMORY_SCOPE_AGENT); }
DI unsigned xb_xcc_id() { return (unsigned)__builtin_amdgcn_s_getreg((3 << 11) | 20) & 0xFu; }
#define XB_SPIN(cond, bar) do { unsigned _sp = 0; while (cond) { __builtin_amdgcn_s_sleep(1); \
    if ((++_sp & 255u) == 0u) { if (xb_ld(&(bar)[XB_TMO])) break; if (_sp > XB_SPIN_CAP) { atomicAdd(&(bar)[XB_TMO], 1u); break; } } } } while (0)
struct XcdBarrier { unsigned* bar; unsigned x; volatile LAS unsigned* st; };
DI XcdBarrier xcd_barrier_post(unsigned* bar, volatile LAS unsigned* st) {
    XcdBarrier b; b.bar = bar; b.x = xb_xcc_id(); b.st = st;
    if (threadIdx.x == 0) (void)xb_add(&bar[XB_XCNT(b.x)], 1u);
    return b;
}
DI void xcd_barrier_complete(unsigned* bar, unsigned x, unsigned& nloc, unsigned& nx) {
    const unsigned G = gridDim.x * gridDim.y * gridDim.z;
    unsigned sum, cnt, mine, sp = 0u;
    for (;;) {
        sum = 0u; cnt = 0u; mine = 0u;
#pragma unroll
        for (unsigned j = 0; j < 16; ++j) { const unsigned c = xb_ld(&bar[XB_XCNT(j)]); sum += c; cnt += (c > 0u) ? 1u : 0u; mine = (j == x) ? c : mine; }
        if (sum == G) break;
        __builtin_amdgcn_s_sleep(1);
        if ((++sp & 255u) == 0u) { if (xb_ld(&bar[XB_TMO])) break; if (sp > XB_SPIN_CAP) { atomicAdd(&bar[XB_TMO], 1u); break; } }
    }
    nloc = mine > 0u ? mine : 1u; nx = cnt > 0u ? cnt : 1u;
}
DI void xcd_barrier(const XcdBarrier& b) {
    asm volatile("s_waitcnt vmcnt(0)" ::: "memory");
    __syncthreads();
    if (threadIdx.x == 0) {
        unsigned* bar = b.bar;
        __builtin_amdgcn_s_waitcnt(0);
        unsigned nloc = b.st[0], nx = b.st[1];
        if (nloc == 0u) { xcd_barrier_complete(bar, b.x, nloc, nx); b.st[0] = nloc; b.st[1] = nx; }
        const unsigned old = xb_add(&bar[XB_XSUB(b.x)], 1u);
        const unsigned gen = old / nloc;
        if (old + 1u == (gen + 1u) * nloc) {
            __builtin_amdgcn_fence(__ATOMIC_RELEASE, "agent");
            asm volatile("s_waitcnt vmcnt(0)" ::: "memory");
            const unsigned og = xb_add(&bar[XB_TOP], 1u);
            const unsigned tg = og / nx;
            if (og + 1u == (tg + 1u) * nx) xb_add(&bar[XB_TOPGEN], 1u);
            else XB_SPIN(xb_ld(&bar[XB_TOPGEN]) == tg, bar);
            __builtin_amdgcn_fence(__ATOMIC_ACQUIRE, "agent");
            xb_add(&bar[XB_XGEN(b.x)], 1u);
            asm volatile("s_waitcnt vmcnt(0)" ::: "memory");
        } else {
            XB_SPIN(xb_ld(&bar[XB_XGEN(b.x)]) == gen, bar);
            __builtin_amdgcn_fence(__ATOMIC_ACQUIRE, "agent");
            asm volatile("s_waitcnt vmcnt(0)" ::: "memory");
        }
    }
    __syncthreads();
}

__global__ void __launch_bounds__(512, 2) mega(Params p) {
    cg::grid_group grid = cg::this_grid();
    unsigned char* smem = dsm;
    bf16_t* WB = (bf16_t*)(p.ws + WS_WB);
    bf16_t* XB = (bf16_t*)(p.ws + WS_XB);
    bf16_t* R1 = (bf16_t*)(p.ws + WS_R1);
    bf16_t* R2 = (bf16_t*)(p.ws + WS_R2);
    bf16_t* Y = R2;
    __shared__ uint4 xb_words;
    unsigned* xbar = (unsigned*)(p.ws + WS_XBAR);
    if (blockIdx.x == 0) { for (int i = threadIdx.x; i < XCD_BAR_WORDS; i += NT) __hip_atomic_store(xbar + i, 0u, __ATOMIC_RELAXED, __HIP_MEMORY_SCOPE_AGENT); }
    if (threadIdx.x == 0) xb_words = make_uint4(0u, 0u, 0u, 0u);
    prep_phase(p);
    wconv_part(p, 0, 0, smem, blockIdx.x, gridDim.x);
    wconv_part(p, 0, 1, smem, blockIdx.x, gridDim.x);
    grid.sync();
    const XcdBarrier gb = xcd_barrier_post(xbar, (volatile LAS unsigned*)&xb_words);
    for (int layer = 0; layer < 4; ++layer) {
        Epi ep{}; ep.out = p.out; ep.layer = layer; ep.rope = (const float2*)(p.ws + WS_ROPE);
        if ((layer & 1) == 0) {
            const int e = layer >> 1;
            bf16_t* H1 = R1; bf16_t* QN = R1 + (size_t)MT * 2304; bf16_t* LAT = QN + (size_t)MT * 384;
            bf16_t* Qb = R2; bf16_t* KB = Qb + (size_t)MT * 768; bf16_t* VT = KB + (size_t)KVROWS * 768;
            ep.b0 = H1; ep.ld = 2304;
            gemm_phase<0>(XB, WB + WB_IN, MT, 2304, 1024, ep);
            { const int G = gridDim.x, rem = (130 * 9) % G;
              if (rem == 0) even_pastcopy(p, e, blockIdx.x, G); else if ((int)blockIdx.x >= rem) even_pastcopy(p, e, blockIdx.x - rem, G - rem); }
            xcd_barrier(gb);
            even_elem(p, e);
            xcd_barrier(gb);
            ep.b0 = Qb;
            gemm_phase<1>(QN, WB + WB_UQ, MT, 768, 384, ep);
            ep.b0 = KB; ep.b1 = VT;
            gemm_phase<2>(LAT, WB + WB_UKV, KVROWS, 1024, 256, ep, 8);
            xcd_barrier(gb);
            attn_phase(p, smem);
            xcd_barrier(gb);
            ep.b0 = Y; ep.ld = 1024;
            gemm_phase<0>((const bf16_t*)p.out, WB + WB_O, MP, 1024, 1024, ep);
            gemm_small((const bf16_t*)p.out, WB + WB_O, 1024, Y);
            xcd_barrier(gb);
        } else {
            const int o = layer >> 1;
            ep.b0 = R1; ep.b1 = (bf16_t*)p.out; ep.f0 = (float*)(p.ws + WS_ABF);
            gemm_phase<3>(XB, WB + WB_IN, MT, 4352, 1024, ep);
            xcd_barrier(gb);
            odd_elem(p, o);
            xcd_barrier(gb);
            delta_prep(p, smem);
            xcd_barrier(gb);
            delta_scan(p, o, smem);
            xcd_barrier(gb);
            odd_gate(p, o);
            xcd_barrier(gb);
            ep.b0 = Y; ep.ld = 1024;
            gemm_phase<0>(R1, WB + WB_O, MP, 1024, 1024, ep);
            gemm_small(R1, WB + WB_O, 1024, Y);
            xcd_barrier(gb);
        }
        ln_phase(p, Y, p.in[24] + layer * 1024, p.in[25] + layer * 1024, false);
        xcd_barrier(gb);
        ep.b0 = R1; ep.f0 = (float*)(p.ws + WS_HALO); ep.f1 = (float*)(p.ws + WS_HEADG); ep.f2 = (float*)(p.ws + WS_HEADU);
        ep.c0 = p.in[22] + (size_t)layer * 3 * 2816; ep.c1 = p.in[7];
        gemm_phase<4>(XB, WB + WB_FI, MT, 5632, 1024, ep);
        if (layer < 3) {
            const int G = gridDim.x, rem = (130 * 22) % G;
            if (rem == 0) wconv_part(p, layer + 1, 0, smem, blockIdx.x, G);
            else if ((int)blockIdx.x >= rem) wconv_part(p, layer + 1, 0, smem, blockIdx.x - rem, G - rem);
        }
        xcd_barrier(gb);
        ffn_fixup(p, layer);
        xcd_barrier(gb);
        ep.b0 = Y; ep.ld = 1024;
        gemm_phase<0>(R1, WB + WB_FO, MP, 1024, 2816, ep);
        gemm_small(R1, WB + WB_FO, 2816, Y);
        xcd_barrier(gb);
        ln_phase(p, Y, p.in[26] + layer * 1024, p.in[27] + layer * 1024, layer == 3);
        if (layer < 3) wconv_part(p, layer + 1, 1, smem, blockIdx.x, gridDim.x);
        xcd_barrier(gb);
    }
}

extern "C" void kernel_launch(void* const* d_in, const int* in_sizes, int n_in, void* d_out, int out_size, void* d_ws, size_t ws_size, hipStream_t stream) {
    if (n_in < 28 || ws_size < WS_NEED || (size_t)out_size < O_END) { fprintf(stderr, "bad sizes: n_in %d ws %zu out %d\n", n_in, ws_size, out_size); return; }
    static int grid_blocks = 0;
    if (!grid_blocks) {
        int dev = 0, cus = 0, per_cu = 0;
        hipGetDevice(&dev);
        hipDeviceGetAttribute(&cus, hipDeviceAttributeMultiprocessorCount, dev);
        hipFuncSetAttribute((const void*)mega, hipFuncAttributeMaxDynamicSharedMemorySize, (int)LDS_BYTES);
        hipOccupancyMaxActiveBlocksPerMultiprocessor(&per_cu, mega, NT, LDS_BYTES);
        if (per_cu > 1) per_cu = 1;
        grid_blocks = cus * per_cu;
        grid_blocks &= ~7;
    }
    Params p{};
    for (int i = 0; i < 28; ++i) p.in[i] = (const float*)d_in[i];
    p.out = (float*)d_out; p.ws = (unsigned char*)d_ws;
    void* args[] = {&p};
    hipError_t e = hipLaunchCooperativeKernel((void*)mega, dim3(grid_blocks), dim3(NT), args, LDS_BYTES, stream);
    if (e != hipSuccess) fprintf(stderr, "cooperative launch failed: %s (grid %d)\n", hipGetErrorString(e), grid_blocks);
}
```

```cpp
#include <hip/hip_runtime.h>
#include <hip/hip_cooperative_groups.h>
#include <cstdio>
#include <cstdint>
namespace cg = cooperative_groups;

typedef unsigned short bf16_t;
typedef short bf16x8 __attribute__((ext_vector_type(8)));
typedef float f32x4 __attribute__((ext_vector_type(4)));
#define DI __device__ __forceinline__
#define MFMA16(a, b, c) __builtin_amdgcn_mfma_f32_16x16x32_bf16((a), (b), (c), 0, 0, 0)

constexpr int MP = 32768, MS = 512, MT = 33280;
constexpr int KVROWS = 32768 + 8 * 2112;
constexpr float ALPHA = 1.681792830507429f;
constexpr float EPS = 1e-6f;

constexpr size_t O_YP = 0;
constexpr size_t O_YS = O_YP + (size_t)4 * 8192 * 1024;
constexpr size_t O_PLAT = O_YS + (size_t)8 * 64 * 1024;
constexpr size_t O_PKR = O_PLAT + (size_t)2 * 4 * 8192 * 256;
constexpr size_t O_PSC = O_PKR + (size_t)2 * 4 * 8192 * 32;
constexpr size_t O_PDC = O_PSC + (size_t)2 * 4 * 2 * 512;
constexpr size_t O_PDS = O_PDC + (size_t)2 * 4 * 3 * 3072;
constexpr size_t O_PFF = O_PDS + (size_t)2 * 4 * 8 * 128 * 128;
constexpr size_t O_SLAT = O_PFF + (size_t)4 * 4 * 2 * 2816;
constexpr size_t O_SKR = O_SLAT + (size_t)2 * 8 * 64 * 256;
constexpr size_t O_SSC = O_SKR + (size_t)2 * 8 * 64 * 32;
constexpr size_t O_SDC = O_SSC + (size_t)2 * 8 * 2 * 512;
constexpr size_t O_SDS = O_SDC + (size_t)2 * 8 * 3 * 3072;
constexpr size_t O_SFF = O_SDS + (size_t)2 * 8 * 8 * 128 * 128;
constexpr size_t O_END = O_SFF + (size_t)4 * 8 * 2 * 2816;

constexpr size_t WS_WB = 0;
constexpr size_t WS_XB = 32ull << 20;
constexpr size_t WS_ROPE = WS_XB + (size_t)MT * 1024 * 2;
constexpr size_t WS_GB = WS_ROPE + 8192 * 16 * 8;
constexpr size_t WS_ABF = WS_GB + (size_t)MT * 16 * 4;
constexpr size_t WS_HALO = WS_ABF + (size_t)MT * 16 * 4;
constexpr size_t WS_HEADG = WS_HALO + (size_t)260 * 2 * 2816 * 4;
constexpr size_t WS_HEADU = WS_HEADG + (size_t)260 * 2 * 2816 * 4;
constexpr size_t WS_R1 = 120ull << 20;
constexpr size_t R_SIZE = (size_t)MT * 3072 * 2;
constexpr size_t WS_R2 = 316ull << 20;
constexpr size_t WS_NEED = WS_R2 + R_SIZE;
static_assert(WS_HEADU + (size_t)260 * 2 * 2816 * 4 <= WS_R1, "ws small region overflow");
static_assert(WS_R1 + R_SIZE <= WS_R2, "ws r1 overflow");
static_assert(WS_NEED <= (512ull << 20), "ws overflow");

constexpr size_t WB_IN = 0;
constexpr size_t WB_UQ = WB_IN + (size_t)4352 * 1024;
constexpr size_t WB_UKV = WB_UQ + (size_t)768 * 384;
constexpr size_t WB_O = WB_UKV + (size_t)1024 * 256;
constexpr size_t WB_FI = WB_O + (size_t)1024 * 1024;
constexpr size_t WB_FO = WB_FI + (size_t)5632 * 1024;
static_assert((WB_FO + (size_t)1024 * 2816) * 2 <= (32ull << 20), "wb overflow");

constexpr int NT = 512;
constexpr unsigned LDS_BYTES = 147456;
extern __shared__ __attribute__((aligned(16))) unsigned char dsm[];

struct Params {
    const float* in[28];
    float* out;
    unsigned char* ws;
};

typedef __bf16 bf16n2 __attribute__((ext_vector_type(2)));
typedef float f32n2 __attribute__((ext_vector_type(2)));
DI bf16_t f2bf(float x) { return __builtin_bit_cast(unsigned short, (__bf16)x); }
DI float bf2f(bf16_t h) { return __uint_as_float(((unsigned)h) << 16); }
DI unsigned pack2(float lo, float hi) { const f32n2 v = {lo, hi}; return __builtin_bit_cast(unsigned, __builtin_convertvector(v, bf16n2)); }
DI float lo16(unsigned u) { return __uint_as_float(u << 16); }
DI float hi16(unsigned u) { return __uint_as_float(u & 0xffff0000u); }
struct F8 { float v[8]; };
DI F8 unpack8(uint4 u) { F8 r; r.v[0] = lo16(u.x); r.v[1] = hi16(u.x); r.v[2] = lo16(u.y); r.v[3] = hi16(u.y); r.v[4] = lo16(u.z); r.v[5] = hi16(u.z); r.v[6] = lo16(u.w); r.v[7] = hi16(u.w); return r; }
DI uint4 pack8(const F8& f) { uint4 u; u.x = pack2(f.v[0], f.v[1]); u.y = pack2(f.v[2], f.v[3]); u.z = pack2(f.v[4], f.v[5]); u.w = pack2(f.v[6], f.v[7]); return u; }
DI F8 ldf8(const float* p) { float4 a = *(const float4*)p, b = *(const float4*)(p + 4); F8 r; r.v[0] = a.x; r.v[1] = a.y; r.v[2] = a.z; r.v[3] = a.w; r.v[4] = b.x; r.v[5] = b.y; r.v[6] = b.z; r.v[7] = b.w; return r; }
DI void stf8(float* p, const F8& f) { *(float4*)p = make_float4(f.v[0], f.v[1], f.v[2], f.v[3]); *(float4*)(p + 4) = make_float4(f.v[4], f.v[5], f.v[6], f.v[7]); }
DI F8 ldb8(const bf16_t* p) { return unpack8(*(const uint4*)p); }
DI void stb8(bf16_t* p, const F8& f) { *(uint4*)p = pack8(f); }
DI float wsum(float v) { v += __shfl_xor(v, 32); v += __shfl_xor(v, 16); v += __shfl_xor(v, 8); v += __shfl_xor(v, 4); v += __shfl_xor(v, 2); v += __shfl_xor(v, 1); return v; }
DI float gsum16(float v) { v += __shfl_xor(v, 8); v += __shfl_xor(v, 4); v += __shfl_xor(v, 2); v += __shfl_xor(v, 1); return v; }
DI float siluf(float x) { return x / (1.f + __expf(-x)); }
DI bf16x8 asbf(uint4 u) { return __builtin_bit_cast(bf16x8, u); }
DI uint4 scale8(uint4 u, float s) { F8 f = unpack8(u); for (int e = 0; e < 8; ++e) f.v[e] *= s; return pack8(f); }

DI int tidx() { int t = threadIdx.x; asm volatile("" : "+v"(t)); return t; }
DI int bidx() { int b = blockIdx.x; asm volatile("" : "+s"(b)); return b; }
DI int gdim() { int g = gridDim.x; asm volatile("" : "+s"(g)); return g; }
DI void rowinfo(int r, int& sq, int& pos, int& len) { if (r < MP) { sq = r >> 13; pos = r & 8191; len = 8192; } else { sq = 4 + ((r - MP) >> 6); pos = r & 63; len = 64; } }
DI int kvrow_of(int r) { return r < MP ? r : MP + ((r - MP) >> 6) * 2112 + 2048 + (r & 63); }

DI void wconv(const float* __restrict__ src, bf16_t* __restrict__ dst, int K, int N, int Npad, int perm, unsigned char* smem) {
    float* tile = (float*)smem;
    const int tid = tidx();
    const int nkt = K >> 6, nnt = (Npad + 63) >> 6, T = nkt * nnt;
    for (int t = bidx(); t < T; t += gdim()) {
        const int kt = t % nkt, ntile = t / nkt, k0 = kt * 64, n0 = ntile * 64;
#pragma unroll
        for (int j = 0; j < 2; ++j) {
            const int k = (tid >> 4) + 32 * j, nl4 = (tid & 15) * 4, n = n0 + nl4;
            float4 v = make_float4(0.f, 0.f, 0.f, 0.f);
            if (n < N) v = *(const float4*)(src + (size_t)(k0 + k) * N + n);
            float* tp = tile + k * 65 + nl4; tp[0] = v.x; tp[1] = v.y; tp[2] = v.z; tp[3] = v.w;
        }
        __syncthreads();
        const int nl = tid >> 3, kc = (tid & 7) * 8, n = n0 + nl;
        if (n < Npad) {
            int nd = n;
            if (perm) nd = n < 2816 ? (n >> 6) * 128 + (n & 63) : ((n - 2816) >> 6) * 128 + 64 + ((n - 2816) & 63);
            F8 a;
#pragma unroll
            for (int e = 0; e < 8; ++e) a.v[e] = tile[(kc + e) * 65 + nl];
            stb8(dst + (size_t)nd * K + k0 + kc, a);
        }
        __syncthreads();
    }
}

DI void wconv_layer(const Params& p, int layer, unsigned char* smem) {
    bf16_t* WB = (bf16_t*)(p.ws + WS_WB);
    if ((layer & 1) == 0) {
        const int e = layer >> 1;
        wconv(p.in[8] + (size_t)e * 1024 * 2208, WB + WB_IN, 1024, 2208, 2304, 0, smem);
        wconv(p.in[11] + (size_t)e * 384 * 768, WB + WB_UQ, 384, 768, 768, 0, smem);
        wconv(p.in[12] + (size_t)e * 256 * 1024, WB + WB_UKV, 256, 1024, 1024, 0, smem);
        wconv(p.in[14] + (size_t)e * 1024 * 1024, WB + WB_O, 1024, 1024, 1024, 0, smem);
    } else {
        const int o = layer >> 1;
        wconv(p.in[15] + (size_t)o * 1024 * 4112, WB + WB_IN, 1024, 4112, 4352, 0, smem);
        wconv(p.in[20] + (size_t)o * 1024 * 1024, WB + WB_O, 1024, 1024, 1024, 0, smem);
    }
    wconv(p.in[21] + (size_t)layer * 1024 * 5632, WB + WB_FI, 1024, 5632, 5632, 1, smem);
    wconv(p.in[23] + (size_t)layer * 2816 * 1024, WB + WB_FO, 2816, 1024, 1024, 0, smem);
}

DI void prep_phase(const Params& p) {
    bf16_t* XB = (bf16_t*)(p.ws + WS_XB);
    const size_t gt = (size_t)bidx() * NT + tidx(), gn = (size_t)gdim() * NT;
    for (size_t i = gt; i < (size_t)MT * 128; i += gn) {
        const size_t e = i * 8;
        const float* s = e < (size_t)MP * 1024 ? p.in[0] + e : p.in[1] + (e - (size_t)MP * 1024);
        stb8(XB + e, ldf8(s));
    }
    float2* R = (float2*)(p.ws + WS_ROPE);
    for (size_t i = gt; i < 8192 * 16; i += gn) {
        const int pos = (int)(i >> 4), j = (int)(i & 15);
        const double base[4] = {1.0, 0.5623413251903491, 0.31622776601683794, 0.1778279410038923};
        double inv = base[j & 3];
        const int q = j >> 2;
        inv = q == 0 ? inv : q == 1 ? inv * 0.1 : q == 2 ? inv * 0.01 : inv * 0.001;
        const float ang = (float)pos * (float)inv;
        const double rev = (double)ang * 0.15915494309189535;
        const float fr = (float)(rev - floor(rev));
        R[i] = make_float2(__builtin_amdgcn_cosf(fr), __builtin_amdgcn_sinf(fr));
    }
}

struct Epi {
    bf16_t* b0; bf16_t* b1; float* f0; float* f1; float* f2;
    const float* c0; const float* c1; const float2* rope;
    float* out; int ld; int layer;
};
constexpr int LDC = 132;

template <int MODE>
DI void gemm_epilogue(const float* Cs, int m0, int n0, const Epi& ep) {
    const int tid = tidx();
    if (MODE == 0) {
#pragma unroll
        for (int it = 0; it < 4; ++it) {
            const int row = (tid >> 4) + 32 * it, cc = (tid & 15) * 8;
            stb8(ep.b0 + (size_t)(m0 + row) * ep.ld + n0 + cc, ldf8(Cs + row * LDC + cc));
        }
    } else if (MODE == 1) {
        const float qs = 0.10206207261596575f * 1.4426950408889634f;
#pragma unroll
        for (int it = 0; it < 4; ++it) {
            const int row = (tid >> 4) + 32 * it, cc = (tid & 15) * 8, col = n0 + cc, hc = col % 96;
            F8 x = ldf8(Cs + row * LDC + cc);
            if (hc >= 64) {
                int sq, pos, len; rowinfo(m0 + row, sq, pos, len); if (sq >= 4) pos += 2048;
                const bool first = hc < 80;
                const int j0 = first ? hc - 64 : hc - 80;
                F8 y = ldf8(Cs + row * LDC + (first ? cc + 16 : cc - 16));
                const float2* rp = ep.rope + pos * 16 + j0;
#pragma unroll
                for (int e = 0; e < 8; ++e) { const float2 cs = rp[e]; x.v[e] = first ? x.v[e] * cs.x - y.v[e] * cs.y : x.v[e] * cs.x + y.v[e] * cs.y; }
            }
#pragma unroll
            for (int e = 0; e < 8; ++e) x.v[e] *= qs;
            stb8(ep.b0 + (size_t)(m0 + row) * 768 + col, x);
        }
    } else if (MODE == 2) {
        const int h = n0 >> 7;
#pragma unroll
        for (int it = 0; it < 2; ++it) {
            const int row = (tid >> 3) + 64 * it, cc = (tid & 7) * 8;
            stb8(ep.b0 + (size_t)(m0 + row) * 768 + h * 96 + cc, ldf8(Cs + row * LDC + cc));
        }
        const int dv = tid >> 3;
#pragma unroll
        for (int jj = 0; jj < 2; ++jj) {
            const int t8 = ((tid & 7) + 8 * jj) * 8, kvr = m0 + t8;
            size_t vb; int Ts, t;
            if (kvr < MP) { vb = (size_t)(kvr >> 13) * (512 * 8192); Ts = 8192; t = kvr & 8191; }
            else { const int s = (kvr - MP) / 2112; vb = (size_t)4 * 512 * 8192 + (size_t)s * (512 * 2112); Ts = 2112; t = kvr - MP - s * 2112; }
            F8 x;
#pragma unroll
            for (int e = 0; e < 8; ++e) x.v[e] = Cs[(t8 + e) * LDC + 64 + dv];
            stb8(ep.b1 + vb + (size_t)(h * 64 + dv) * Ts + t, x);
        }
    } else if (MODE == 3) {
        if (n0 < 4224) {
        bf16_t* dst = n0 < 3072 ? ep.b0 : ep.b1;
        const int ld = n0 < 3072 ? 3072 : 1152, c0 = n0 < 3072 ? n0 : n0 - 3072;
#pragma unroll
        for (int it = 0; it < 4; ++it) {
            const int row = (tid >> 4) + 32 * it, cc = (tid & 15) * 8;
            stb8(dst + (size_t)(m0 + row) * ld + c0 + cc, ldf8(Cs + row * LDC + cc));
        }
        if (n0 == 4096) {
            const int row = tid >> 2, c4 = (tid & 3) * 4;
            *(float4*)(ep.f0 + (size_t)(m0 + row) * 16 + c4) = *(const float4*)(Cs + row * LDC + c4);
        }
        }
    } else if (MODE == 4) {
        const int mt = m0 >> 7, ch0 = (n0 >> 7) * 64, c8 = (tid & 7) * 8, ch = ch0 + c8;
        const float* cw = ep.c0;
        const F8 w0 = ldf8(cw + ch), w1 = ldf8(cw + 2816 + ch), w2 = ldf8(cw + 2 * 2816 + ch);
        const bool defer01 = (m0 < MP) && ((m0 & 8191) != 0);
#pragma unroll
        for (int it = 0; it < 2; ++it) {
            const int i = (tid >> 3) + 64 * it, r = m0 + i;
            int sq, pos, len; rowinfo(r, sq, pos, len);
            const F8 g0 = ldf8(Cs + i * LDC + c8), up = ldf8(Cs + i * LDC + 64 + c8);
            if (i >= 126) stf8(ep.f0 + ((size_t)mt * 2 + (i - 126)) * 2816 + ch, g0);
            if (i < 2) { stf8(ep.f1 + ((size_t)mt * 2 + i) * 2816 + ch, g0); stf8(ep.f2 + ((size_t)mt * 2 + i) * 2816 + ch, up); }
            if (pos >= len - 2) {
                float* so = sq < 4 ? ep.out + O_PFF + (((size_t)ep.layer * 4 + sq) * 2 + (pos - (len - 2))) * 2816
                                   : ep.out + O_SFF + (((size_t)ep.layer * 8 + (sq - 4)) * 2 + (pos - (len - 2))) * 2816;
                stf8(so + ch, g0);
            }
            if (i < 2 && defer01) continue;
            F8 g1, g2;
            const float* hist = sq >= 4 ? ep.c1 + ((size_t)ep.layer * 8 + (sq - 4)) * 2 * 2816 + ch : nullptr;
            if (pos >= 1) g1 = ldf8(Cs + (i - 1) * LDC + c8);
            else if (hist) g1 = ldf8(hist + 2816);
            else { for (int e = 0; e < 8; ++e) g1.v[e] = 0.f; }
            if (pos >= 2) g2 = ldf8(Cs + (i - 2) * LDC + c8);
            else if (hist) g2 = ldf8(hist + (size_t)pos * 2816);
            else { for (int e = 0; e < 8; ++e) g2.v[e] = 0.f; }
            F8 o;
#pragma unroll
            for (int e = 0; e < 8; ++e) o.v[e] = siluf(w0.v[e] * g2.v[e] + w1.v[e] * g1.v[e] + w2.v[e] * g0.v[e]) * up.v[e];
            stb8(ep.b0 + (size_t)r * 2816 + ch, o);
        }
    }
}

namespace g8 {
constexpr int BM = 256, BK = 64, HALF = 128, NXCD = 8, WGM = 8, HT = HALF * BK;
DI int lds_byte(int r, int c) { int st = (r >> 4) * 2 + (c >> 5), rr = r & 15, cc = c & 31, ob = rr * 64 + cc * 2; return st * 1024 + (ob ^ (((ob >> 9) & 1) << 5)); }
DI void stage_rc(int b, int& R, int& C) { int st = b / 1024, sb = b % 1024, swz = sb ^ (((sb >> 9) & 1) << 5); R = (st >> 1) * 16 + swz / 64; C = (st & 1) * 32 + (swz % 64) / 2; }
}
template <int MODE>
DI void gemm_phase(const bf16_t* __restrict__ A, const bf16_t* __restrict__ Bt, int M, int N, int K, const Epi& ep) {
    using namespace g8;
    bf16_t* shm = (bf16_t*)dsm;
    float* Cs = (float*)dsm;
#define SA(b, h) (shm + ((b) * 2 + (h)) * HT)
#define SB(b, h) (shm + (4 + (b) * 2 + (h)) * HT)
#define STAGE(P, RS, br, kt) do { const unsigned _so = (unsigned)(((size_t)(br) * K + (size_t)(kt) * BK) * 2); \
    __builtin_amdgcn_raw_ptr_buffer_load_lds(RS, (__attribute__((address_space(3))) void*)((char*)(P) + tid * 16), 16, goff0, _so, 0, 0); \
    __builtin_amdgcn_raw_ptr_buffer_load_lds(RS, (__attribute__((address_space(3))) void*)((char*)(P) + tid * 16 + 8192), 16, goff1, _so, 0, 0); } while (0)
#define LDA(dst, b, h) for (int m = 0; m < 4; ++m) for (int k = 0; k < 2; ++k) \
    dst[m][k] = *reinterpret_cast<const bf16x8*>((char*)SA(b, h) + lds_byte(wr * 64 + m * 16 + fr, k * 32 + fq * 8))
#define LDB(dst, b, h) for (int n = 0; n < 2; ++n) for (int k = 0; k < 2; ++k) \
    dst[n][k] = *reinterpret_cast<const bf16x8*>((char*)SB(b, h) + lds_byte(wc * 32 + n * 16 + fr, k * 32 + fq * 8))
#define MMA(ai, bj, At, Bt_) do { __builtin_amdgcn_s_setprio(1); \
    for (int m = 0; m < 4; ++m) for (int n = 0; n < 2; ++n) for (int k = 0; k < 2; ++k) \
      acc[ai][bj][m][n] = __builtin_amdgcn_mfma_f32_16x16x32_bf16(Bt_[n][k], At[m][k], acc[ai][bj][m][n], 0, 0, 0); \
    __builtin_amdgcn_s_setprio(0); } while (0)
#define WAIT_V(n) asm volatile("s_waitcnt vmcnt(" #n ")" ::: "memory")
#define WAIT_L(n) asm volatile("s_waitcnt lgkmcnt(" #n ")" ::: "memory")
#define BAR __builtin_amdgcn_s_barrier()
#define SCHED __builtin_amdgcn_sched_barrier(0)
    const int tid = tidx(), G = gdim(), bid = bidx();
    const int nM = M / BM, nN = N / BM, nwg = nM * nN;
    const int wid = tid >> 6, lane = tid & 63, wr = wid >> 2, wc = wid & 3, fr = lane & 15, fq = lane >> 4;
    const int nt = K / BK;
    unsigned goff0, goff1;
    const __amdgpu_buffer_rsrc_t rsA = __builtin_amdgcn_make_buffer_rsrc((void*)A, (short)0, 0x7fffffff, 0x00020000);
    const __amdgpu_buffer_rsrc_t rsB = __builtin_amdgcn_make_buffer_rsrc((void*)Bt, (short)0, 0x7fffffff, 0x00020000);
    { int r_, c_; stage_rc(tid * 16, r_, c_); goff0 = (unsigned)(r_ * K + c_) * 2u; stage_rc(tid * 16 + 8192, r_, c_); goff1 = (unsigned)(r_ * K + c_) * 2u; }
    for (int round = 0;; ++round) {
        const int L = round * G + bid;
        if (L >= nwg) break;
        int wgid = L;
        { const int q = nwg / NXCD, r = nwg % NXCD, xcd = wgid % NXCD, off = wgid / NXCD; wgid = (xcd < r ? xcd * (q + 1) : r * (q + 1) + (xcd - r) * q) + off; }
        const int nig = WGM * nN, gid = wgid / nig, fm = gid * WGM, gsz = min(nM - fm, WGM);
        const int pm = fm + ((wgid % nig) % gsz), pn = (wgid % nig) / gsz, brow = pm * BM, bcol = pn * BM;
        f32x4 acc[2][2][4][2] = {};
        bf16x8 At[4][2], B0[2][2], B1[2][2];
        WAIT_V(0);
        STAGE(SB(0, 0), rsB, bcol, 0); STAGE(SB(0, 1), rsB, bcol + HALF, 0); STAGE(SA(0, 0), rsA, brow, 0); STAGE(SA(0, 1), rsA, brow + HALF, 0);
        if (wr == 1) BAR;
        WAIT_V(2); BAR;
        STAGE(SB(1, 0), rsB, bcol, 1); STAGE(SA(1, 0), rsA, brow, 1); STAGE(SB(1, 1), rsB, bcol + HALF, 1);
        WAIT_V(6); BAR;
        for (int t = 0; t < nt - 2; t += 2) {
            LDB(B0, 0, 0); LDB(B1, 0, 1); SCHED; LDA(At, 0, 0); STAGE(SA(1, 1), rsA, brow + HALF, t + 1);
            WAIT_V(8); WAIT_L(0); BAR; MMA(0, 0, At, B0); MMA(0, 1, At, B1); BAR; SCHED;
            LDA(At, 0, 1); STAGE(SB(0, 0), rsB, bcol, t + 2); STAGE(SB(0, 1), rsB, bcol + HALF, t + 2); STAGE(SA(0, 0), rsA, brow, t + 2);
            WAIT_V(8); WAIT_L(0); BAR; MMA(1, 0, At, B0); MMA(1, 1, At, B1); BAR; SCHED;
            LDB(B0, 1, 0); LDB(B1, 1, 1); SCHED; LDA(At, 1, 0); STAGE(SA(0, 1), rsA, brow + HALF, t + 2);
            WAIT_V(8); WAIT_L(0); BAR; MMA(0, 0, At, B0); MMA(0, 1, At, B1); BAR; SCHED;
            LDA(At, 1, 1); STAGE(SB(1, 0), rsB, bcol, t + 3); STAGE(SB(1, 1), rsB, bcol + HALF, t + 3); STAGE(SA(1, 0), rsA, brow, t + 3);
            WAIT_V(8); WAIT_L(0); BAR; MMA(1, 0, At, B0); MMA(1, 1, At, B1); BAR; SCHED;
        }
        {
            LDB(B0, 0, 0); LDB(B1, 0, 1); SCHED; LDA(At, 0, 0); STAGE(SA(1, 1), rsA, brow + HALF, nt - 1);
            WAIT_V(8); WAIT_L(0); BAR; MMA(0, 0, At, B0); MMA(0, 1, At, B1); BAR; SCHED;
            LDA(At, 0, 1);
            WAIT_V(2); WAIT_L(0); BAR; MMA(1, 0, At, B0); MMA(1, 1, At, B1); BAR; SCHED;
            LDB(B0, 1, 0); LDB(B1, 1, 1); SCHED; LDA(At, 1, 0);
            WAIT_V(0); WAIT_L(0); BAR; MMA(0, 0, At, B0); MMA(0, 1, At, B1); BAR; SCHED;
            LDA(At, 1, 1);
            WAIT_L(0); BAR; MMA(1, 0, At, B0); MMA(1, 1, At, B1); BAR; SCHED;
        }
        if (wr == 0) BAR;
        __syncthreads();
#pragma unroll
        for (int ai = 0; ai < 2; ++ai)
#pragma unroll
            for (int bj = 0; bj < 2; ++bj) {
#pragma unroll
                for (int m = 0; m < 4; ++m)
#pragma unroll
                    for (int n = 0; n < 2; ++n)
                        *(f32x4*)(Cs + (wr * 64 + m * 16 + fr) * LDC + wc * 32 + n * 16 + fq * 4) = acc[ai][bj][m][n];
                __syncthreads();
                gemm_epilogue<MODE>(Cs, brow + ai * 128, bcol + bj * 128, ep);
                __syncthreads();
            }
    }
#undef SA
#undef SB
#undef STAGE
#undef LDA
#undef LDB
#undef MMA
#undef WAIT_V
#undef WAIT_L
#undef BAR
#undef SCHED
}

DI void gemm_small(const bf16_t* __restrict__ A, const bf16_t* __restrict__ Bt, int K, bf16_t* __restrict__ Yo) {
    const int tid = tidx(), lane = tid & 63, wave = tid >> 6, fr = lane & 15, g = lane >> 4;
    for (int t = bidx(); t < 256; t += gdim()) {
        const int row = MP + (t >> 4) * 32 + (wave >> 2) * 16, col = (t & 15) * 64 + (wave & 3) * 16;
        const bf16_t* ap = A + (size_t)(row + fr) * K + 8 * g;
        const bf16_t* bp = Bt + (size_t)(col + fr) * K + 8 * g;
        f32x4 acc = (f32x4){0.f, 0.f, 0.f, 0.f};
        for (int k0 = 0; k0 < K; k0 += 256) {
            uint4 av[8], bv[8];
#pragma unroll
            for (int j = 0; j < 8; ++j) { av[j] = *(const uint4*)(ap + k0 + 32 * j); bv[j] = *(const uint4*)(bp + k0 + 32 * j); }
#pragma unroll
            for (int j = 0; j < 8; ++j) acc = MFMA16(asbf(av[j]), asbf(bv[j]), acc);
        }
#pragma unroll
        for (int e = 0; e < 4; ++e) Yo[(size_t)(row + 4 * g + e) * 1024 + col + fr] = f2bf(acc[e]);
    }
}

DI void ffn_fixup(const Params& p, int layer) {
    const float* HALO = (const float*)(p.ws + WS_HALO); const float* HG = (const float*)(p.ws + WS_HEADG); const float* HU = (const float*)(p.ws + WS_HEADU);
    bf16_t* ACT = (bf16_t*)(p.ws + WS_R1);
    const float* cw = p.in[22] + (size_t)layer * 3 * 2816;
    const size_t gt = (size_t)bidx() * NT + tidx(), gn = (size_t)gdim() * NT;
    for (size_t i = gt; i < (size_t)256 * 2 * 352; i += gn) {
        const int c = (int)(i % 352) * 8, ri = (int)((i / 352) & 1), mt = (int)(i / 704);
        if ((mt & 63) == 0) continue;
        const F8 w0 = ldf8(cw + c), w1 = ldf8(cw + 2816 + c), w2 = ldf8(cw + 5632 + c);
        F8 g0, g1, g2;
        if (ri == 0) { g0 = ldf8(HG + ((size_t)mt * 2) * 2816 + c); g1 = ldf8(HALO + ((size_t)(mt - 1) * 2 + 1) * 2816 + c); g2 = ldf8(HALO + ((size_t)(mt - 1) * 2) * 2816 + c); }
        else { g0 = ldf8(HG + ((size_t)mt * 2 + 1) * 2816 + c); g1 = ldf8(HG + ((size_t)mt * 2) * 2816 + c); g2 = ldf8(HALO + ((size_t)(mt - 1) * 2 + 1) * 2816 + c); }
        const F8 up = ldf8(HU + ((size_t)mt * 2 + ri) * 2816 + c);
        F8 o;
#pragma unroll
        for (int e = 0; e < 8; ++e) o.v[e] = siluf(w0.v[e] * g2.v[e] + w1.v[e] * g1.v[e] + w2.v[e] * g0.v[e]) * up.v[e];
        stb8(ACT + ((size_t)mt * 128 + ri) * 2816 + c, o);
    }
}

DI void ln_phase(const Params& p, const bf16_t* __restrict__ Y, const float* __restrict__ g, const float* __restrict__ b, bool final_out) {
    bf16_t* XB = (bf16_t*)(p.ws + WS_XB);
    const int lane = tidx() & 63, gw = (bidx() * NT + tidx()) >> 6, nw = (gdim() * NT) >> 6;
    F8 gg[2], bb[2];
#pragma unroll
    for (int it = 0; it < 2; ++it) { gg[it] = ldf8(g + it * 512 + lane * 8); bb[it] = ldf8(b + it * 512 + lane * 8); }
    for (int r0 = gw; r0 < MT; r0 += 2 * nw) {
        const int r1 = r0 + nw; const bool two = r1 < MT; const int rr[2] = {r0, two ? r1 : r0};
        uint4 xr[2][2], yr[2][2];
#pragma unroll
        for (int q = 0; q < 2; ++q)
#pragma unroll
            for (int it = 0; it < 2; ++it) { const size_t off = (size_t)rr[q] * 1024 + it * 512 + lane * 8; xr[q][it] = *(const uint4*)(XB + off); yr[q][it] = *(const uint4*)(Y + off); }
        float v[2][16];
#pragma unroll
        for (int q = 0; q < 2; ++q)
#pragma unroll
            for (int it = 0; it < 2; ++it) { const F8 x = unpack8(xr[q][it]), y = unpack8(yr[q][it]);
#pragma unroll
                for (int e = 0; e < 8; ++e) v[q][it * 8 + e] = ALPHA * x.v[e] + y.v[e]; }
        float s0 = 0.f, s1 = 0.f;
#pragma unroll
        for (int e = 0; e < 16; ++e) { s0 += v[0][e]; s1 += v[1][e]; }
        const float mu0 = wsum(s0) * (1.f / 1024.f), mu1 = wsum(s1) * (1.f / 1024.f);
        float q0 = 0.f, q1 = 0.f;
#pragma unroll
        for (int e = 0; e < 16; ++e) { const float d0 = v[0][e] - mu0, d1 = v[1][e] - mu1; q0 += d0 * d0; q1 += d1 * d1; }
        const float rs0 = rsqrtf(wsum(q0) * (1.f / 1024.f) + EPS), rs1 = rsqrtf(wsum(q1) * (1.f / 1024.f) + EPS);
#pragma unroll
        for (int q = 0; q < 2; ++q) {
            if (q == 1 && !two) break;
            const float mu = q ? mu1 : mu0, rs = q ? rs1 : rs0;
#pragma unroll
            for (int it = 0; it < 2; ++it) {
                const int c = it * 512 + lane * 8;
                F8 o;
#pragma unroll
                for (int e = 0; e < 8; ++e) o.v[e] = (v[q][it * 8 + e] - mu) * rs * gg[it].v[e] + bb[it].v[e];
                if (final_out) stf8(p.out + (size_t)rr[q] * 1024 + c, o);
                else stb8(XB + (size_t)rr[q] * 1024 + c, o);
            }
        }
    }
}

DI void even_elem(const Params& p, int e) {
    const bf16_t* H1 = (const bf16_t*)(p.ws + WS_R1);
    bf16_t* QN = (bf16_t*)(p.ws + WS_R1 + (size_t)MT * 2304 * 2);
    bf16_t* LAT = QN + (size_t)MT * 384;
    bf16_t* KB = (bf16_t*)(p.ws + WS_R2 + (size_t)MT * 768 * 2);
    bf16_t* CAT = (bf16_t*)p.out;
    const float2* ROPE = (const float2*)(p.ws + WS_ROPE);
    const float* gq = p.in[9] + e * 384; const float* gkv = p.in[10] + e * 256; const float* scw = p.in[13] + e * 3 * 512;
    const int lane = tidx() & 63, gw = (bidx() * NT + tidx()) >> 6, nw = (gdim() * NT) >> 6;
    {
        const int lq = lane < 48 ? lane : 47, lk = lane < 32 ? lane : 31, lr = lane < 2 ? lane : 1;
        const F8 gqv = ldf8(gq + lq * 8), gkvv = ldf8(gkv + lk * 8);
        for (int ra = gw; ra < MT; ra += 2 * nw) {
            const bool two = ra + nw < MT; const int rr[2] = {ra, two ? ra + nw : ra};
            uint4 xq[2], xkv[2], x1[2], x2[2];
#pragma unroll
            for (int q = 0; q < 2; ++q) { const bf16_t* hr = H1 + (size_t)rr[q] * 2304;
                xq[q] = *(const uint4*)(hr + lq * 8); xkv[q] = *(const uint4*)(hr + 384 + lk * 8); x1[q] = *(const uint4*)(hr + 640 + lr * 8); x2[q] = *(const uint4*)(hr + 656 + lr * 8); }
#pragma unroll
            for (int q = 0; q < 2; ++q) {
                if (q == 1 && !two) break;
                const int r = rr[q]; int sq, pos, len; rowinfo(r, sq, pos, len);
                const int kvr = kvrow_of(r), apos = sq >= 4 ? pos + 2048 : pos;
                { F8 x = unpack8(xq[q]); float ss = 0.f;
                  if (lane < 48) { for (int k = 0; k < 8; ++k) ss += x.v[k] * x.v[k]; }
                  const float rs = rsqrtf(wsum(ss) * (1.f / 384.f) + EPS);
                  if (lane < 48) { for (int k = 0; k < 8; ++k) x.v[k] *= rs * gqv.v[k]; stb8(QN + (size_t)r * 384 + lane * 8, x); } }
                { F8 x = unpack8(xkv[q]); float ss = 0.f;
                  if (lane < 32) { for (int k = 0; k < 8; ++k) ss += x.v[k] * x.v[k]; }
                  const float rs = rsqrtf(wsum(ss) * (1.f / 256.f) + EPS);
                  if (lane < 32) { for (int k = 0; k < 8; ++k) x.v[k] *= rs * gkvv.v[k];
                      float* lo = sq < 4 ? p.out + O_PLAT + (((size_t)e * 4 + sq) * 8192 + pos) * 256 : p.out + O_SLAT + (((size_t)e * 8 + (sq - 4)) * 64 + pos) * 256;
                      stf8(lo + lane * 8, x); stb8(LAT + (size_t)kvr * 256 + lane * 8, x); } }
                if (lane < 2) {
                    const F8 a1 = unpack8(x1[q]), a2 = unpack8(x2[q]);
                    F8 o1, o2; const float2* rp = ROPE + apos * 16 + lane * 8;
#pragma unroll
                    for (int k = 0; k < 8; ++k) { const float2 cs = rp[k]; o1.v[k] = a1.v[k] * cs.x - a2.v[k] * cs.y; o2.v[k] = a2.v[k] * cs.x + a1.v[k] * cs.y; }
                    float* ko = sq < 4 ? p.out + O_PKR + (((size_t)e * 4 + sq) * 8192 + pos) * 32 : p.out + O_SKR + (((size_t)e * 8 + (sq - 4)) * 64 + pos) * 32;
                    stf8(ko + lane * 8, o1); stf8(ko + 16 + lane * 8, o2);
#pragma unroll
                    for (int h = 0; h < 8; ++h) { stb8(KB + (size_t)kvr * 768 + h * 96 + 64 + lane * 8, o1); stb8(KB + (size_t)kvr * 768 + h * 96 + 80 + lane * 8, o2); }
                }
            }
        }
    }
    {
        const int c = lane * 8;
        const F8 w0 = ldf8(scw + c), w1 = ldf8(scw + 512 + c), w2 = ldf8(scw + 1024 + c);
        for (int ck = gw; ck < MT / 8; ck += nw) {
            const int r0 = ck * 8; int sq, pos0, len; rowinfo(r0, sq, pos0, len);
            const bf16_t* hp = H1 + (size_t)r0 * 2304 + c;
            uint4 gbr[8], gcr[8], shr[8];
#pragma unroll
            for (int t = 0; t < 8; ++t) { gbr[t] = *(const uint4*)(hp + (size_t)t * 2304 + 672); gcr[t] = *(const uint4*)(hp + (size_t)t * 2304 + 1184); shr[t] = *(const uint4*)(hp + (size_t)t * 2304 + 1696); }
            F8 a1, a2;
            if (pos0 > 0) { const F8 u1 = ldb8(hp - 2304 + 1184), v1 = ldb8(hp - 2304 + 1696), u2 = ldb8(hp - 4608 + 1184), v2 = ldb8(hp - 4608 + 1696);
                            for (int k = 0; k < 8; ++k) { a1.v[k] = u1.v[k] * v1.v[k]; a2.v[k] = u2.v[k] * v2.v[k]; } }
            else if (sq >= 4) { const float* hist = p.in[4] + ((size_t)e * 8 + (sq - 4)) * 2 * 512 + c; a1 = ldf8(hist + 512); a2 = ldf8(hist); }
            else { for (int k = 0; k < 8; ++k) { a1.v[k] = 0.f; a2.v[k] = 0.f; } }
            const bool last = (pos0 + 8 == len);
#pragma unroll
            for (int t = 0; t < 8; ++t) {
                const F8 gb = unpack8(gbr[t]), gc = unpack8(gcr[t]), sh = unpack8(shr[t]);
                F8 a0, o;
#pragma unroll
                for (int k = 0; k < 8; ++k) { a0.v[k] = gc.v[k] * sh.v[k]; o.v[k] = gb.v[k] * (w0.v[k] * a2.v[k] + w1.v[k] * a1.v[k] + w2.v[k] * a0.v[k]); }
                stb8(CAT + (size_t)(r0 + t) * 1024 + 512 + c, o);
                if (last && t >= 6) {
                    float* so = sq < 4 ? p.out + O_PSC + (((size_t)e * 4 + sq) * 2 + (t - 6)) * 512 : p.out + O_SSC + (((size_t)e * 8 + (sq - 4)) * 2 + (t - 6)) * 512;
                    stf8(so + c, a0);
                }
                a2 = a1; a1 = a0;
            }
        }
    }
    for (int j0 = gw; j0 < 8 * 2048; j0 += 4 * nw) {
        F8 v[4];
#pragma unroll
        for (int q = 0; q < 4; ++q) {
            const int j = j0 + q * nw < 8 * 2048 ? j0 + q * nw : j0, s = j >> 11, t = j & 2047;
            v[q] = lane < 32 ? ldf8(p.in[2] + (((size_t)e * 8 + s) * 2048 + t) * 256 + lane * 8)
                             : ldf8(p.in[3] + (((size_t)e * 8 + s) * 2048 + t) * 32 + ((lane - 32) & 3) * 8);
        }
#pragma unroll
        for (int q = 0; q < 4; ++q) {
            const int j = j0 + q * nw; if (j >= 8 * 2048) break;
            const int s = j >> 11, t = j & 2047, kvr = MP + s * 2112 + t;
            if (lane < 32) stb8(LAT + (size_t)kvr * 256 + lane * 8, v[q]);
            else { const int h = (lane - 32) >> 2, cc = ((lane - 32) & 3) * 8; stb8(KB + (size_t)kvr * 768 + h * 96 + 64 + cc, v[q]); }
        }
    }
}

DI void attn_phase(const Params& p, unsigned char* smem) {
    const bf16_t* Q = (const bf16_t*)(p.ws + WS_R2);
    const bf16_t* KB = Q + (size_t)MT * 768;
    const bf16_t* VT = KB + (size_t)KVROWS * 768;
    bf16_t* CAT = (bf16_t*)p.out;
    const int tid = tidx(), lane = tid & 63, wave = tid >> 6, fr = lane & 15, g = lane >> 4;
    constexpr int KST = 112, VST = 136, BUF = 128 * KST + 64 * VST;
    bf16_t* sbuf = (bf16_t*)smem;
    const int G = gdim();
    for (int i = 0; i * G < 1088; ++i) {
        const int idx = (i & 1) ? (i * G + (G - 1 - bidx())) : (i * G + bidx());
        if (idx >= 1088) continue;
        int h, qrow0, kvbase, ntiles, Ts, wtiles; size_t vb;
        if (idx < 1024) { const int jt = 31 - (idx >> 5), bh = idx & 31, b = bh >> 3; h = bh & 7; qrow0 = b * 8192 + jt * 256; kvbase = b * 8192; ntiles = 4 * jt + 4;
                          vb = (size_t)b * (512 * 8192); Ts = 8192; wtiles = 4 * jt + 1 + (wave >> 1); }
        else { const int u = idx - 1024, s = u >> 3; h = u & 7; qrow0 = MP + 64 * s; kvbase = MP + s * 2112; ntiles = 33;
               vb = (size_t)4 * 512 * 8192 + (size_t)s * (512 * 2112); Ts = 2112; wtiles = wave < 2 ? 33 : 0; }
        bf16x8 qf[2][3];
#pragma unroll
        for (int qs = 0; qs < 2; ++qs)
#pragma unroll
            for (int s = 0; s < 3; ++s) {
                uint4 u = make_uint4(0, 0, 0, 0);
                if (wtiles > 0) u = *(const uint4*)(Q + (size_t)(qrow0 + 32 * wave + 16 * qs + fr) * 768 + h * 96 + 32 * s + 8 * g);
                qf[qs][s] = asbf(u);
            }
        f32x4 ot[4][2];
#pragma unroll
        for (int a = 0; a < 4; ++a)
#pragma unroll
            for (int b = 0; b < 2; ++b) ot[a][b] = (f32x4){0.f, 0.f, 0.f, 0.f};
        float mrow[2] = {0.f, 0.f}, lrow[2] = {0.f, 0.f};
        const int kr0 = tid / 12, kr1 = (tid + 512) / 12, kr2 = (tid + 1024) / 12;
        const int kh0 = tid - kr0 * 12, kh1 = tid + 512 - kr1 * 12, kh2 = tid + 1024 - kr2 * 12;
        const int kd0 = kr0 * KST + kh0 * 8, kd1 = kr1 * KST + kh1 * 8, kd2 = kr2 * KST + kh2 * 8;
        const int ko0 = kr0 * 768 + kh0 * 8, ko1 = kr1 * 768 + kh1 * 8, ko2 = kr2 * 768 + kh2 * 8;
        const bf16_t* kbase = KB + (size_t)kvbase * 768 + h * 96;
        const int vch = tid & 15, vdv0 = tid >> 4, vdv1 = vdv0 + 32;
        const int vd0 = 128 * KST + vdv0 * VST + vch * 8, vd1 = 128 * KST + vdv1 * VST + vch * 8;
        const bf16_t* vbase = VT + vb + (size_t)(h * 64) * Ts + vch * 8;
        const size_t vo0 = (size_t)vdv0 * Ts, vo1 = (size_t)vdv1 * Ts;
        const int nst = (ntiles + 1) >> 1;
        unsigned zz = 0; asm volatile("" : "+v"(zz));
        uint4 rk0, rk1 = make_uint4(zz, zz, zz, zz), rk2 = rk1, rv0 = rk1, rv1 = rk1;
        { const bool h2 = 1 < ntiles;
          rk0 = *(const uint4*)(kbase + ko0);
          if (kr1 < 64 || h2) rk1 = *(const uint4*)(kbase + ko1);
          if (h2) rk2 = *(const uint4*)(kbase + ko2);
          if (vch < 8 || h2) { rv0 = *(const uint4*)(vbase + vo0); rv1 = *(const uint4*)(vbase + vo1); } }
        *(uint4*)(sbuf + kd0) = rk0; *(uint4*)(sbuf + kd1) = rk1; *(uint4*)(sbuf + kd2) = rk2;
        *(uint4*)(sbuf + vd0) = rv0; *(uint4*)(sbuf + vd1) = rv1;
        __syncthreads();
        for (int st_ = 0; st_ < nst; ++st_) {
            const int cur = st_ & 1;
            if (st_ + 1 < nst) {
                const bool h2 = 2 * st_ + 3 < ntiles;
                const bf16_t* kb2 = kbase + (size_t)(st_ + 1) * 128 * 768; const bf16_t* vb2 = vbase + (st_ + 1) * 128;
                rk0 = *(const uint4*)(kb2 + ko0);
                if (kr1 < 64 || h2) rk1 = *(const uint4*)(kb2 + ko1);
                if (h2) rk2 = *(const uint4*)(kb2 + ko2);
                if (vch < 8 || h2) { rv0 = *(const uint4*)(vb2 + vo0); rv1 = *(const uint4*)(vb2 + vo1); }
            }
#pragma unroll
            for (int hf = 0; hf < 2; ++hf) {
                if (2 * st_ + hf < wtiles) {
                    const bf16_t* sK = sbuf + cur * BUF + hf * 64 * KST; const bf16_t* sV = sbuf + cur * BUF + 128 * KST + hf * 64;
                    bf16x8 kf[4][3];
#pragma unroll
                    for (int kk = 0; kk < 4; ++kk)
#pragma unroll
                        for (int s = 0; s < 3; ++s) kf[kk][s] = *(const bf16x8*)(sK + (16 * kk + fr) * KST + 32 * s + 8 * g);
#pragma unroll
                    for (int qs = 0; qs < 2; ++qs) {
                        f32x4 st[4];
                        const float nm = -mrow[qs];
#pragma unroll
                        for (int kk = 0; kk < 4; ++kk) {
                            st[kk] = (f32x4){nm, nm, nm, nm};
#pragma unroll
                            for (int s = 0; s < 3; ++s) st[kk] = MFMA16(kf[kk][s], qf[qs][s], st[kk]);
                        }
                        float mx = fmaxf(fmaxf(st[0][0], st[0][1]), fmaxf(st[0][2], st[0][3]));
#pragma unroll
                        for (int kk = 1; kk < 4; ++kk) mx = fmaxf(mx, fmaxf(fmaxf(st[kk][0], st[kk][1]), fmaxf(st[kk][2], st[kk][3])));
                        const bool first = (st_ == 0 && hf == 0);
                        if (first || __any(mx > 6.f)) {
                            mx = fmaxf(mx, __shfl_xor(mx, 16)); mx = fmaxf(mx, __shfl_xor(mx, 32));
                            const float shift = first ? mx : fmaxf(mx, 0.f);
                            const float al = first ? 1.f : __builtin_amdgcn_exp2f(-shift);
                            mrow[qs] += shift; lrow[qs] *= al;
#pragma unroll
                            for (int dt = 0; dt < 4; ++dt) ot[dt][qs] *= al;
#pragma unroll
                            for (int kk = 0; kk < 4; ++kk)
#pragma unroll
                                for (int e = 0; e < 4; ++e) st[kk][e] -= shift;
                        }
                        float rs = 0.f;
#pragma unroll
                        for (int kk = 0; kk < 4; ++kk)
#pragma unroll
                            for (int e = 0; e < 4; ++e) { const float pv = __builtin_amdgcn_exp2f(st[kk][e]); st[kk][e] = pv; rs += pv; }
                        lrow[qs] += rs;
#pragma unroll
                        for (int s2 = 0; s2 < 2; ++s2) {
                            uint4 u; u.x = pack2(st[2 * s2][0], st[2 * s2][1]); u.y = pack2(st[2 * s2][2], st[2 * s2][3]);
                            u.z = pack2(st[2 * s2 + 1][0], st[2 * s2 + 1][1]); u.w = pack2(st[2 * s2 + 1][2], st[2 * s2 + 1][3]);
                            const bf16x8 pf = asbf(u);
#pragma unroll
                            for (int dt = 0; dt < 4; ++dt) {
                                const uint2 a = *(const uint2*)(sV + (16 * dt + fr) * VST + 32 * s2 + 4 * g), b = *(const uint2*)(sV + (16 * dt + fr) * VST + 32 * s2 + 16 + 4 * g);
                                ot[dt][qs] = MFMA16(asbf(make_uint4(a.x, a.y, b.x, b.y)), pf, ot[dt][qs]);
                            }
                        }
                    }
                }
            }
            if (st_ + 1 < nst) {
                bf16_t* d = sbuf + (cur ^ 1) * BUF;
                *(uint4*)(d + kd0) = rk0; *(uint4*)(d + kd1) = rk1; *(uint4*)(d + kd2) = rk2;
                *(uint4*)(d + vd0) = rv0; *(uint4*)(d + vd1) = rv1;
            }
            __syncthreads();
        }
        if (wtiles > 0) {
#pragma unroll
            for (int qs = 0; qs < 2; ++qs) {
                float l = lrow[qs]; l += __shfl_xor(l, 16); l += __shfl_xor(l, 32);
                const float inv = 1.f / l;
                const int row = qrow0 + 32 * wave + 16 * qs + fr;
#pragma unroll
                for (int dt = 0; dt < 4; ++dt) {
                    uint2 o; o.x = pack2(ot[dt][qs][0] * inv, ot[dt][qs][1] * inv); o.y = pack2(ot[dt][qs][2] * inv, ot[dt][qs][3] * inv);
                    *(uint2*)(CAT + (size_t)row * 1024 + h * 64 + 16 * dt + 4 * g) = o;
                }
            }
        }
    }
}

DI void odd_elem(const Params& p, int o) {
    const bf16_t* QR = (const bf16_t*)(p.ws + WS_R1);
    bf16_t* Q2 = (bf16_t*)(p.ws + WS_R2);
    const float* ABF = (const float*)(p.ws + WS_ABF);
    float* GB = (float*)(p.ws + WS_GB);
    const float* cw = p.in[16] + (size_t)o * 4 * 3072;
    const int lane = tidx() & 63, gw = (bidx() * NT + tidx()) >> 6, nw = (gdim() * NT) >> 6;
    for (int item = gw; item < 2080 * 6; item += nw) {
        const int chunk = item / 6, gi = item - chunk * 6, r0 = chunk * 16, c = gi * 512 + lane * 8;
        int sq, pos0, len; rowinfo(r0, sq, pos0, len);
        const bf16_t* xp = QR + (size_t)r0 * 3072 + c;
        uint4 xr[16];
#pragma unroll
        for (int t = 0; t < 16; ++t) xr[t] = *(const uint4*)(xp + (size_t)t * 3072);
        F8 h1, h2, h3;
        if (pos0 > 0) { h1 = ldb8(xp - 3072); h2 = ldb8(xp - 2 * 3072); h3 = ldb8(xp - 3 * 3072); }
        else if (sq >= 4) { const float* hist = p.in[5] + ((size_t)o * 8 + (sq - 4)) * 3 * 3072 + c; h1 = ldf8(hist + 2 * 3072); h2 = ldf8(hist + 3072); h3 = ldf8(hist); }
        else { for (int k = 0; k < 8; ++k) { h1.v[k] = 0.f; h2.v[k] = 0.f; h3.v[k] = 0.f; } }
        const F8 w0 = ldf8(cw + c), w1 = ldf8(cw + 3072 + c), w2 = ldf8(cw + 2 * 3072 + c), w3 = ldf8(cw + 3 * 3072 + c);
        const bool last = (pos0 + 16 == len);
        const float nsc = gi < 2 ? 0.08838834764831845f : 1.f;
#pragma unroll
        for (int t = 0; t < 16; ++t) {
            const F8 x0 = unpack8(xr[t]);
            F8 acc; float ss = 0.f;
#pragma unroll
            for (int k = 0; k < 8; ++k) { const float a = w3.v[k] * x0.v[k] + w2.v[k] * h1.v[k] + w1.v[k] * h2.v[k] + w0.v[k] * h3.v[k]; acc.v[k] = siluf(a); ss += acc.v[k] * acc.v[k]; }
            if (gi < 4) {
                const float rs = rsqrtf(gsum16(ss) + EPS) * nsc;
#pragma unroll
                for (int k = 0; k < 8; ++k) acc.v[k] *= rs;
            }
            stb8(Q2 + (size_t)(r0 + t) * 3072 + c, acc);
            if (last && t >= 13) {
                float* so = sq < 4 ? p.out + O_PDC + (((size_t)o * 4 + sq) * 3 + (t - 13)) * 3072 : p.out + O_SDC + (((size_t)o * 8 + (sq - 4)) * 3 + (t - 13)) * 3072;
                stf8(so + c, x0);
            }
            h3 = h2; h2 = h1; h1 = x0;
        }
        if (gi == 0) {
#pragma unroll
            for (int k = 0; k < 2; ++k) {
                const int pi = lane + 64 * k, r = r0 + (pi >> 3), hd = pi & 7;
                const float a = ABF[(size_t)r * 16 + hd], bt = ABF[(size_t)r * 16 + 8 + hd];
                const float xx = a + p.in[18][o * 8 + hd];
                const float ey = __expf(xx);
                const float sp = xx > 20.f ? xx : (ey < 0.01f ? ey * (1.f - ey * (0.5f - ey * (1.f / 3.f))) : __logf(1.f + ey));
                GB[(size_t)r * 16 + hd] = -__expf(p.in[17][o * 8 + hd]) * sp;
                GB[(size_t)r * 16 + 8 + hd] = 1.f / (1.f + __expf(-bt));
            }
        }
    }
}

constexpr int MST = 68;
DI void delta_prep(const Params& p, unsigned char* smem) {
    const bf16_t* Q2 = (const bf16_t*)(p.ws + WS_R2);
    const float* GB = (const float*)(p.ws + WS_GB);
    bf16_t* TB = (bf16_t*)(p.ws + WS_R1 + (size_t)MT * 1024 * 2);
    bf16_t* ATB = TB + (size_t)4160 * 4096;
    float* SCB = (float*)(ATB + (size_t)4160 * 4096);
    const int tid = tidx(), lane = tid & 63, wave = tid >> 6, fr = lane & 15, g = lane >> 4;
    float* Ms = (float*)smem + wave * (64 * MST + 128);
    float* sG = Ms + 64 * MST; float* sBt = sG + 64;
    for (int base = bidx() * 8; base < 4160; base += gdim() * 8) {
        const int u = base + wave, c = u >> 3, h = u & 7, r0 = c * 64;
        float Gv = GB[(size_t)(r0 + lane) * 16 + h];
        const float beta = GB[(size_t)(r0 + lane) * 16 + 8 + h];
#pragma unroll
        for (int off = 1; off < 64; off <<= 1) { const float t = __shfl_up(Gv, off); if (lane >= off) Gv += t; }
        sG[lane] = Gv; sBt[lane] = beta;
        { const float gl = __shfl(Gv, 63), eg = __expf(Gv);
          float* sc = SCB + (size_t)u * 256;
          sc[lane] = beta * eg; sc[64 + lane] = eg; sc[128 + lane] = __expf(gl - Gv); sc[192 + lane] = beta; }
        asm volatile("s_waitcnt lgkmcnt(0)" ::: "memory");
        const bf16_t* kbp = Q2 + (size_t)(r0 + fr) * 3072 + 1024 + h * 128 + 8 * g;
        const bf16_t* qbp = Q2 + (size_t)(r0 + fr) * 3072 + h * 128 + 8 * g;
        bf16_t* ao = ATB + (size_t)u * 4096;
#pragma unroll
        for (int it = 0; it < 4; ++it) {
            bf16x8 qf[4], ki[4];
#pragma unroll
            for (int s = 0; s < 4; ++s) { qf[s] = asbf(*(const uint4*)(qbp + (size_t)16 * it * 3072 + 32 * s)); ki[s] = asbf(*(const uint4*)(kbp + (size_t)16 * it * 3072 + 32 * s)); }
#pragma unroll
            for (int jt = 0; jt < 4; ++jt) {
                if (jt > it) {
#pragma unroll
                    for (int e = 0; e < 4; ++e) ao[(16 * it + 4 * g + e) * 64 + 16 * jt + fr] = 0;
                    continue;
                }
                f32x4 kk = (f32x4){0.f, 0.f, 0.f, 0.f}, qk = (f32x4){0.f, 0.f, 0.f, 0.f};
#pragma unroll
                for (int s = 0; s < 4; ++s) {
                    const bf16x8 kj = asbf(*(const uint4*)(kbp + (size_t)16 * jt * 3072 + 32 * s));
                    kk = MFMA16(ki[s], kj, kk); qk = MFMA16(qf[s], kj, qk);
                }
                const int j = 16 * jt + fr; const float Gj = sG[j];
#pragma unroll
                for (int e = 0; e < 4; ++e) {
                    const int i = 16 * it + 4 * g + e;
                    const float Gi = sG[i], bi = sBt[i];
                    const float dec = (j <= i) ? __expf(Gi - Gj) : 0.f;
                    Ms[i * MST + j] = (j < i) ? bi * kk[e] * dec : 0.f;
                    ao[i * 64 + j] = f2bf(qk[e] * dec);
                }
            }
        }
        asm volatile("s_waitcnt lgkmcnt(0)" ::: "memory");
        float T[64];
#pragma unroll
        for (int i = 0; i < 64; ++i) T[i] = 0.f;
#pragma unroll
        for (int i = 0; i < 64; ++i) {
            float a = (lane == i) ? 1.f : 0.f;
#pragma unroll
            for (int j4 = 0; j4 * 4 < i; ++j4) {
                const float4 m = *(const float4*)(Ms + i * MST + 4 * j4);
                a -= m.x * T[4 * j4] + m.y * T[4 * j4 + 1] + m.z * T[4 * j4 + 2] + m.w * T[4 * j4 + 3];
            }
            T[i] = a;
        }
        bf16_t* to = TB + (size_t)u * 4096;
#pragma unroll
        for (int i = 0; i < 64; ++i) to[i * 64 + lane] = f2bf(T[i]);
        asm volatile("s_waitcnt lgkmcnt(0)" ::: "memory");
    }
}

struct ScanLd { uint4 aK[4]; uint4 aQ[4]; uint4 aT[2]; uint4 aA[2]; unsigned vv[4]; float4 scK, scQ, kt, be; float gt; };
DI void scan_load(ScanLd& L, const bf16_t* Q2, const float* SCB, const bf16_t* TB, const bf16_t* ATB, int ch, int h, int sl, int wave, int lane) {
    const int fr = lane & 15, g = lane >> 4, r0 = ch * 64, uidx = ch * 8 + h;
    const bf16_t* rowp = Q2 + (size_t)(r0 + 16 * wave + fr) * 3072 + h * 128 + 8 * g;
#pragma unroll
    for (int s = 0; s < 4; ++s) { L.aQ[s] = *(const uint4*)(rowp + 32 * s); L.aK[s] = *(const uint4*)(rowp + 1024 + 32 * s); }
#pragma unroll
    for (int s = 0; s < 2; ++s) { L.aT[s] = *(const uint4*)(TB + (size_t)uidx * 4096 + (16 * wave + fr) * 64 + 32 * s + 8 * g);
                                  L.aA[s] = *(const uint4*)(ATB + (size_t)uidx * 4096 + (16 * wave + fr) * 64 + 32 * s + 8 * g); }
#pragma unroll
    for (int e = 0; e < 4; ++e) L.vv[e] = (unsigned)Q2[(size_t)(r0 + 16 * wave + 4 * g + e) * 3072 + 2048 + h * 128 + sl * 16 + fr];
    const float* sc = SCB + (size_t)uidx * 256 + 16 * wave + 4 * g;
    L.scK = *(const float4*)(sc); L.scQ = *(const float4*)(sc + 64); L.kt = *(const float4*)(sc + 128); L.be = *(const float4*)(sc + 192);
    L.gt = SCB[(size_t)uidx * 256 + 64 + 63];
}
DI void scan_step(const ScanLd& cur, f32x4 (&S)[2], bf16_t* OB, bf16_t* sST, bf16_t* sUT, bf16_t* sVT, bf16_t* sV2, bf16_t* kT, int r0, int h, int sl, int wave, int lane) {
    const int fr = lane & 15, g = lane >> 4;
#pragma unroll
    for (int m = 0; m < 2; ++m) { uint2 w; w.x = pack2(S[m][0], S[m][1]); w.y = pack2(S[m][2], S[m][3]); *(uint2*)(sST + fr * 136 + 16 * (2 * wave + m) + 4 * g) = w; }
    asm volatile("s_waitcnt lgkmcnt(0)" ::: "memory"); __builtin_amdgcn_s_barrier(); asm volatile("" ::: "memory");
    f32x4 ks = (f32x4){0.f, 0.f, 0.f, 0.f}, oo = (f32x4){0.f, 0.f, 0.f, 0.f};
#pragma unroll
    for (int s = 0; s < 4; ++s) {
        const bf16x8 bS = *(const bf16x8*)(sST + fr * 136 + 32 * s + 8 * g);
        ks = MFMA16(asbf(cur.aK[s]), bS, ks);
        oo = MFMA16(asbf(cur.aQ[s]), bS, oo);
    }
#pragma unroll
    for (int s = 0; s < 4; ++s) {
        const uint4 kv = cur.aK[s]; const unsigned w4[4] = {kv.x, kv.y, kv.z, kv.w};
#pragma unroll
        for (int e = 0; e < 4; ++e) { kT[(32 * s + 8 * g + 2 * e) * 72 + 16 * wave + fr] = (bf16_t)(w4[e] & 0xffffu); kT[(32 * s + 8 * g + 2 * e + 1) * 72 + 16 * wave + fr] = (bf16_t)(w4[e] >> 16); }
    }
    { uint2 w; w.x = pack2(lo16(cur.vv[0]) * cur.be.x - cur.scK.x * ks[0], lo16(cur.vv[1]) * cur.be.y - cur.scK.y * ks[1]);
      w.y = pack2(lo16(cur.vv[2]) * cur.be.z - cur.scK.z * ks[2], lo16(cur.vv[3]) * cur.be.w - cur.scK.w * ks[3]);
      *(uint2*)(sUT + fr * 72 + 16 * wave + 4 * g) = w; }
    oo[0] *= cur.scQ.x; oo[1] *= cur.scQ.y; oo[2] *= cur.scQ.z; oo[3] *= cur.scQ.w;
    asm volatile("s_waitcnt lgkmcnt(0)" ::: "memory"); __builtin_amdgcn_s_barrier(); asm volatile("" ::: "memory");
    f32x4 vn = (f32x4){0.f, 0.f, 0.f, 0.f};
#pragma unroll
    for (int s = 0; s < 2; ++s) vn = MFMA16(asbf(cur.aT[s]), *(const bf16x8*)(sUT + fr * 72 + 32 * s + 8 * g), vn);
    { uint2 w; w.x = pack2(vn[0], vn[1]); w.y = pack2(vn[2], vn[3]); *(uint2*)(sVT + fr * 72 + 16 * wave + 4 * g) = w;
      uint2 w2; w2.x = pack2(vn[0] * cur.kt.x, vn[1] * cur.kt.y); w2.y = pack2(vn[2] * cur.kt.z, vn[3] * cur.kt.w); *(uint2*)(sV2 + fr * 72 + 16 * wave + 4 * g) = w2; }
    asm volatile("s_waitcnt lgkmcnt(0)" ::: "memory"); __builtin_amdgcn_s_barrier(); asm volatile("" ::: "memory");
#pragma unroll
    for (int s = 0; s < 2; ++s) oo = MFMA16(asbf(cur.aA[s]), *(const bf16x8*)(sVT + fr * 72 + 32 * s + 8 * g), oo);
#pragma unroll
    for (int e = 0; e < 4; ++e) OB[(size_t)(r0 + 16 * wave + 4 * g + e) * 1024 + h * 128 + sl * 16 + fr] = f2bf(oo[e]);
    bf16x8 b2[2];
#pragma unroll
    for (int s = 0; s < 2; ++s) b2[s] = *(const bf16x8*)(sV2 + fr * 72 + 32 * s + 8 * g);
#pragma unroll
    for (int m = 0; m < 2; ++m) {
        S[m] *= cur.gt;
#pragma unroll
        for (int s = 0; s < 2; ++s) S[m] = MFMA16(*(const bf16x8*)(kT + (16 * (2 * wave + m) + fr) * 72 + 32 * s + 8 * g), b2[s], S[m]);
    }
}
DI void delta_scan(const Params& p, int o, unsigned char* smem) {
    const bf16_t* Q2 = (const bf16_t*)(p.ws + WS_R2);
    bf16_t* OB = (bf16_t*)(p.ws + WS_R1);
    const bf16_t* TB = (const bf16_t*)(p.ws + WS_R1 + (size_t)MT * 1024 * 2);
    const bf16_t* ATB = TB + (size_t)4160 * 4096;
    const float* SCB = (const float*)(ATB + (size_t)4160 * 4096);
    const int tid = tidx(), lane = tid & 63, wave = tid >> 6, fr = lane & 15, g = lane >> 4;
    const bool act = wave < 4;
    bf16_t* sST = (bf16_t*)smem;
    bf16_t* sUT = sST + 16 * 136;
    bf16_t* sVT = sUT + 16 * 72;
    bf16_t* sV2 = sVT + 16 * 72;
    bf16_t* sKT = sV2 + 16 * 72;
    for (int u = bidx(); u < 256 + 512; u += gdim()) {
        int h, sl, c0, nsteps; const float* s_in; float* s_out;
        if (u < 256) { const int bh = (u & 7) + 8 * (u >> 6), b = bh >> 3; sl = (u >> 3) & 7; h = bh & 7; c0 = b * 128; nsteps = 128; s_in = nullptr;
                       s_out = p.out + O_PDS + (((size_t)o * 4 + b) * 8 + h) * 16384; }
        else { const int v = u - 256, s = v >> 6; h = (v >> 3) & 7; sl = v & 7; c0 = 512 + s; nsteps = 1;
               s_in = p.in[6] + (((size_t)o * 8 + s) * 8 + h) * 16384; s_out = p.out + O_SDS + (((size_t)o * 8 + s) * 8 + h) * 16384; }
        if (act) {
            f32x4 S[2];
#pragma unroll
            for (int m = 0; m < 2; ++m)
#pragma unroll
                for (int e = 0; e < 4; ++e) S[m][e] = s_in ? s_in[(size_t)(16 * (2 * wave + m) + 4 * g + e) * 128 + sl * 16 + fr] : 0.f;
            ScanLd A, B;
            const int clast = c0 + nsteps - 1;
            scan_load(A, Q2, SCB, TB, ATB, c0, h, sl, wave, lane);
            for (int n = 0; n < nsteps; n += 2) {
                scan_load(B, Q2, SCB, TB, ATB, min(c0 + n + 1, clast), h, sl, wave, lane);
                scan_step(A, S, OB, sST, sUT, sVT, sV2, sKT, (c0 + n) * 64, h, sl, wave, lane);
                if (n + 1 >= nsteps) break;
                scan_load(A, Q2, SCB, TB, ATB, min(c0 + n + 2, clast), h, sl, wave, lane);
                scan_step(B, S, OB, sST, sUT, sVT, sV2, sKT + 128 * 72, (c0 + n + 1) * 64, h, sl, wave, lane);
            }
#pragma unroll
            for (int m = 0; m < 2; ++m)
#pragma unroll
                for (int e = 0; e < 4; ++e) s_out[(size_t)(16 * (2 * wave + m) + 4 * g + e) * 128 + sl * 16 + fr] = S[m][e];
        } else {
            for (int n = 0; n < nsteps; ++n) { __builtin_amdgcn_s_barrier(); __builtin_amdgcn_s_barrier(); __builtin_amdgcn_s_barrier(); }
        }
        __syncthreads();
    }
}

DI void odd_gate(const Params& p, int o) {
    bf16_t* OB = (bf16_t*)(p.ws + WS_R1);
    const bf16_t* ZAB = (const bf16_t*)p.out;
    const float* go = p.in[19] + o * 128;
    const int lane = tidx() & 63, gw = (bidx() * NT + tidx()) >> 6, nw = (gdim() * NT) >> 6;
    for (int r = gw; r < MT; r += nw) {
#pragma unroll
        for (int it = 0; it < 2; ++it) {
            const int c = it * 512 + lane * 8;
            F8 x = ldb8(OB + (size_t)r * 1024 + c); const F8 z = ldb8(ZAB + (size_t)r * 1152 + c), gg = ldf8(go + (c & 127));
            float ss = 0.f;
            for (int k = 0; k < 8; ++k) ss += x.v[k] * x.v[k];
            const float rs = rsqrtf(gsum16(ss) * (1.f / 128.f) + EPS);
            for (int k = 0; k < 8; ++k) x.v[k] = x.v[k] * rs * gg.v[k] * siluf(z.v[k]);
            stb8(OB + (size_t)r * 1024 + c, x);
        }
    }
}

#define XB_TMO      128
#define XB_XCNT(j)  (256  + 64 * (j))
#define XB_XSUB(j)  (1280 + 64 * (j))
#define XB_XGEN(j)  (2304 + 64 * (j))
#define XB_TOP      3328
#define XB_TOPGEN   3392
#define XCD_BAR_WORDS 3456
#define XB_SPIN_CAP (1u << 18)
#define LAS __attribute__((address_space(3)))
constexpr size_t WS_XBAR = WS_R1 - 16384;
DI unsigned xb_ld(unsigned* p)              { return __hip_atomic_load(p, __ATOMIC_RELAXED, __HIP_MEMORY_SCOPE_AGENT); }
DI unsigned xb_add(unsigned* p, unsigned v) { return __hip_atomic_fetch_add(p, v, __ATOMIC_RELAXED, __HIP_MEMORY_SCOPE_AGENT); }
DI unsigned xb_xcc_id() { return (unsigned)__builtin_amdgcn_s_getreg((3 << 11) | 20) & 0xFu; }
#define XB_SPIN(cond, bar) do { unsigned _sp = 0; while (cond) { __builtin_amdgcn_s_sleep(1); \
    if ((++_sp & 255u) == 0u) { if (xb_ld(&(bar)[XB_TMO])) break; if (_sp > XB_SPIN_CAP) { atomicAdd(&(bar)[XB_TMO], 1u); break; } } } } while (0)
struct XcdBarrier { unsigned* bar; unsigned x; volatile LAS unsigned* st; };
DI XcdBarrier xcd_barrier_post(unsigned* bar, volatile LAS unsigned* st) {
    XcdBarrier b; b.bar = bar; b.x = xb_xcc_id(); b.st = st;
    if (threadIdx.x == 0) (void)xb_add(&bar[XB_XCNT(b.x)], 1u);
    return b;
}
DI void xcd_barrier_complete(unsigned* bar, unsigned x, unsigned& nloc, unsigned& nx) {
    const unsigned G = gridDim.x * gridDim.y * gridDim.z;
    unsigned sum, cnt, mine, sp = 0u;
    for (;;) {
        sum = 0u; cnt = 0u; mine = 0u;
#pragma unroll
        for (unsigned j = 0; j < 16; ++j) { const unsigned c = xb_ld(&bar[XB_XCNT(j)]); sum += c; cnt += (c > 0u) ? 1u : 0u; mine = (j == x) ? c : mine; }
        if (sum == G) break;
        __builtin_amdgcn_s_sleep(1);
        if ((++sp & 255u) == 0u) { if (xb_ld(&bar[XB_TMO])) break; if (sp > XB_SPIN_CAP) { atomicAdd(&bar[XB_TMO], 1u); break; } }
    }
    nloc = mine > 0u ? mine : 1u; nx = cnt > 0u ? cnt : 1u;
}
DI void xcd_barrier(const XcdBarrier& b) {
    asm volatile("s_waitcnt vmcnt(0)" ::: "memory");
    __syncthreads();
    if (threadIdx.x == 0) {
        unsigned* bar = b.bar;
        __builtin_amdgcn_s_waitcnt(0);
        unsigned nloc = b.st[0], nx = b.st[1];
        if (nloc == 0u) { xcd_barrier_complete(bar, b.x, nloc, nx); b.st[0] = nloc; b.st[1] = nx; }
        const unsigned old = xb_add(&bar[XB_XSUB(b.x)], 1u);
        const unsigned gen = old / nloc;
        if (old + 1u == (gen + 1u) * nloc) {
            __builtin_amdgcn_fence(__ATOMIC_RELEASE, "agent");
            asm volatile("s_waitcnt vmcnt(0)" ::: "memory");
            const unsigned og = xb_add(&bar[XB_TOP], 1u);
            const unsigned tg = og / nx;
            if (og + 1u == (tg + 1u) * nx) xb_add(&bar[XB_TOPGEN], 1u);
            else XB_SPIN(xb_ld(&bar[XB_TOPGEN]) == tg, bar);
            __builtin_amdgcn_fence(__ATOMIC_ACQUIRE, "agent");
            xb_add(&bar[XB_XGEN(b.x)], 1u);
            asm volatile("s_waitcnt vmcnt(0)" ::: "memory");
        } else {
            XB_SPIN(xb_ld(&bar[XB_XGEN(b.x)]) == gen, bar);
            __builtin_amdgcn_fence(__ATOMIC_ACQUIRE, "agent");
            asm volatile("s_waitcnt vmcnt(0)" ::: "memory");
        }
    }
    __syncthreads();
}

__global__ void __launch_bounds__(512, 2) mega(Params p) {
    cg::grid_group grid = cg::this_grid();
    unsigned char* smem = dsm;
    bf16_t* WB = (bf16_t*)(p.ws + WS_WB);
    bf16_t* XB = (bf16_t*)(p.ws + WS_XB);
    bf16_t* R1 = (bf16_t*)(p.ws + WS_R1);
    bf16_t* R2 = (bf16_t*)(p.ws + WS_R2);
    bf16_t* Y = R2;
    __shared__ uint4 xb_words;
    unsigned* xbar = (unsigned*)(p.ws + WS_XBAR);
    if (blockIdx.x == 0) { for (int i = threadIdx.x; i < XCD_BAR_WORDS; i += NT) __hip_atomic_store(xbar + i, 0u, __ATOMIC_RELAXED, __HIP_MEMORY_SCOPE_AGENT); }
    if (threadIdx.x == 0) xb_words = make_uint4(0u, 0u, 0u, 0u);
    prep_phase(p);
    wconv_layer(p, 0, smem);
    grid.sync();
    const XcdBarrier gb = xcd_barrier_post(xbar, (volatile LAS unsigned*)&xb_words);
    for (int layer = 0; layer < 4; ++layer) {
        Epi ep{}; ep.out = p.out; ep.layer = layer; ep.rope = (const float2*)(p.ws + WS_ROPE);
        if ((layer & 1) == 0) {
            const int e = layer >> 1;
            bf16_t* H1 = R1; bf16_t* QN = R1 + (size_t)MT * 2304; bf16_t* LAT = QN + (size_t)MT * 384;
            bf16_t* Qb = R2; bf16_t* KB = Qb + (size_t)MT * 768; bf16_t* VT = KB + (size_t)KVROWS * 768;
            ep.b0 = H1; ep.ld = 2304;
            gemm_phase<0>(XB, WB + WB_IN, MT, 2304, 1024, ep);
            xcd_barrier(gb);
            even_elem(p, e);
            xcd_barrier(gb);
            ep.b0 = Qb;
            gemm_phase<1>(QN, WB + WB_UQ, MT, 768, 384, ep);
            ep.b0 = KB; ep.b1 = VT;
            gemm_phase<2>(LAT, WB + WB_UKV, KVROWS, 1024, 256, ep);
            xcd_barrier(gb);
            attn_phase(p, smem);
            xcd_barrier(gb);
            ep.b0 = Y; ep.ld = 1024;
            gemm_phase<0>((const bf16_t*)p.out, WB + WB_O, MP, 1024, 1024, ep);
            gemm_small((const bf16_t*)p.out, WB + WB_O, 1024, Y);
            xcd_barrier(gb);
        } else {
            const int o = layer >> 1;
            ep.b0 = R1; ep.b1 = (bf16_t*)p.out; ep.f0 = (float*)(p.ws + WS_ABF);
            gemm_phase<3>(XB, WB + WB_IN, MT, 4352, 1024, ep);
            xcd_barrier(gb);
            odd_elem(p, o);
            xcd_barrier(gb);
            delta_prep(p, smem);
            xcd_barrier(gb);
            delta_scan(p, o, smem);
            xcd_barrier(gb);
            odd_gate(p, o);
            xcd_barrier(gb);
            ep.b0 = Y; ep.ld = 1024;
            gemm_phase<0>(R1, WB + WB_O, MP, 1024, 1024, ep);
            gemm_small(R1, WB + WB_O, 1024, Y);
            xcd_barrier(gb);
        }
        ln_phase(p, Y, p.in[24] + layer * 1024, p.in[25] + layer * 1024, false);
        xcd_barrier(gb);
        ep.b0 = R1; ep.f0 = (float*)(p.ws + WS_HALO); ep.f1 = (float*)(p.ws + WS_HEADG); ep.f2 = (float*)(p.ws + WS_HEADU);
        ep.c0 = p.in[22] + (size_t)layer * 3 * 2816; ep.c1 = p.in[7];
        gemm_phase<4>(XB, WB + WB_FI, MT, 5632, 1024, ep);
        xcd_barrier(gb);
        ffn_fixup(p, layer);
        xcd_barrier(gb);
        ep.b0 = Y; ep.ld = 1024;
        gemm_phase<0>(R1, WB + WB_FO, MP, 1024, 2816, ep);
        gemm_small(R1, WB + WB_FO, 2816, Y);
        xcd_barrier(gb);
        ln_phase(p, Y, p.in[26] + layer * 1024, p.in[27] + layer * 1024, layer == 3);
        if (layer < 3) wconv_layer(p, layer + 1, smem);
        xcd_barrier(gb);
    }
}

extern "C" void kernel_launch(void* const* d_in, const int* in_sizes, int n_in, void* d_out, int out_size, void* d_ws, size_t ws_size, hipStream_t stream) {
    if (n_in < 28 || ws_size < WS_NEED || (size_t)out_size < O_END) { fprintf(stderr, "bad sizes: n_in %d ws %zu out %d\n", n_in, ws_size, out_size); return; }
    static int grid_blocks = 0;
    if (!grid_blocks) {
        int dev = 0, cus = 0, per_cu = 0;
        hipGetDevice(&dev);
        hipDeviceGetAttribute(&cus, hipDeviceAttributeMultiprocessorCount, dev);
        hipFuncSetAttribute((const void*)mega, hipFuncAttributeMaxDynamicSharedMemorySize, (int)LDS_BYTES);
        hipOccupancyMaxActiveBlocksPerMultiprocessor(&per_cu, mega, NT, LDS_BYTES);
        if (per_cu > 1) per_cu = 1;
        grid_blocks = cus * per_cu;
        grid_blocks &= ~7;
    }
    Params p{};
    for (int i = 0; i < 28; ++i) p.in[i] = (const float*)d_in[i];
    p.out = (float*)d_out; p.ws = (unsigned char*)d_ws;
    void* args[] = {&p};
    hipError_t e = hipLaunchCooperativeKernel((void*)mega, dim3(grid_blocks), dim3(NT), args, LDS_BYTES, stream);
    if (e != hipSuccess) fprintf(stderr, "cooperative launch failed: %s (grid %d)\n", hipGetErrorString(e), grid_blocks);
}
```
